# Optimizing an MI355X kernel written in HIP

```python
import math
import jax, jax.numpy as jnp
from jax import lax
import numpy as np

D_MODEL = 4096
BATCH = 1
SEQ = 16384
DEPTH = 2

F_GROUPS = 4
F_GROUP_DIM = 256
F_WIDTH = F_GROUPS * F_GROUP_DIM
MLA_HEADS = 8
QK_NOPE = 128
QK_ROPE = 64
V_DIM = 128
Q_LORA = 768
KV_LORA = 512
ROPE_THETA = 10000.0
Q_BLOCK = 128
MLA_WIDTH = MLA_HEADS * V_DIM
SG_GROUPS = 16
SG_GROUP_DIM = 128
SG_WIDTH = SG_GROUPS * SG_GROUP_DIM
CHUNK = 128
N_BRANCH = 3
OFF_F = 0
OFF_CQ = OFF_F + F_WIDTH
OFF_CKV = OFF_CQ + Q_LORA
OFF_KR = OFF_CKV + KV_LORA
OFF_SG = OFF_KR + QK_ROPE
N_IN = OFF_SG + 2 * SG_WIDTH
MEM_TOKENS = 256
MEM_HEADS = 4
MEM_HEAD_DIM = 256
MEM_WIDTH = MEM_HEADS * MEM_HEAD_DIM
D_FF = 11008
CONV_WIDTH = 3
EPS = 1e-6

kernel_name = "hybrid_fourier_mla_sgmlp_encoder"


def rms_norm(x, g):
    xf = x.astype(jnp.float32)
    y = xf * lax.rsqrt(jnp.mean(xf * xf, axis=-1, keepdims=True) + EPS)
    return (y * g.astype(jnp.float32)).astype(x.dtype)


def layer_norm(x, g):
    xf = x.astype(jnp.float32)
    mu = jnp.mean(xf, axis=-1, keepdims=True)
    xc = xf - mu
    y = xc * lax.rsqrt(jnp.mean(xc * xc, axis=-1, keepdims=True) + EPS)
    return (y * g.astype(jnp.float32)).astype(x.dtype)


def apply_rope(t, cos, sin):
    cos = cos.astype(t.dtype)
    sin = sin.astype(t.dtype)
    t1, t2 = t[..., : QK_ROPE // 2], t[..., QK_ROPE // 2:]
    return jnp.concatenate([t1 * cos - t2 * sin, t2 * cos + t1 * sin], axis=-1)


def fourier_branch(z):
    B, S, _ = z.shape
    zg = z.reshape(B, S, F_GROUPS, F_GROUP_DIM).astype(jnp.float32)
    y = jnp.fft.fft2(zg, axes=(1, 3), norm="ortho").real
    return y.reshape(B, S, F_WIDTH).astype(z.dtype)


def mla_branch(c_q, c_kv, k_rope, cos, sin, q_norm, w_uq, kv_norm, w_ukv):
    B, S, _ = c_q.shape
    q = (rms_norm(c_q, q_norm) @ w_uq).reshape(B, S, MLA_HEADS, QK_NOPE + QK_ROPE)
    q_nope = q[..., :QK_NOPE]
    q_rope = apply_rope(q[..., QK_NOPE:], cos[:, :, None, :], sin[:, :, None, :])
    kv = (rms_norm(c_kv, kv_norm) @ w_ukv).reshape(B, S, MLA_HEADS, QK_NOPE + V_DIM)
    k_nope, v = kv[..., :QK_NOPE], kv[..., QK_NOPE:]
    k_rope = apply_rope(k_rope, cos, sin)
    scale = 1.0 / math.sqrt(QK_NOPE + QK_ROPE)
    nb = S // Q_BLOCK

    def to_blocks(t):
        return t.reshape(B, nb, Q_BLOCK, MLA_HEADS, t.shape[-1]).swapaxes(0, 1)

    def attend(qs):
        qn, qr = qs
        s = (jnp.einsum('bqhd,bkhd->bhqk', qn, k_nope)
             + jnp.einsum('bqhr,bkr->bhqk', qr, k_rope))
        p = jax.nn.softmax(s.astype(jnp.float32) * scale, axis=-1).astype(v.dtype)
        return jnp.einsum('bhqk,bkhd->bqhd', p, v)

    o = lax.map(attend, (to_blocks(q_nope), to_blocks(q_rope)))
    return o.swapaxes(0, 1).reshape(B, S, MLA_WIDTH)


def spatial_gating_branch(z, ln_gain, w_spatial, b_spatial):
    B, S, _ = z.shape
    z = jax.nn.gelu(z)
    u, v = z[..., :SG_WIDTH], z[..., SG_WIDTH:]
    v = layer_norm(v.reshape(B, S, SG_GROUPS, SG_GROUP_DIM),
                   ln_gain.reshape(SG_GROUPS, SG_GROUP_DIM))
    v = v.reshape(B, S // CHUNK, CHUNK, SG_GROUPS, SG_GROUP_DIM)
    s = (jnp.einsum('gpq,bcqgd->bcpgd', w_spatial, v)
         + b_spatial.T[None, None, :, :, None])
    return u * s.reshape(B, S, SG_WIDTH)


def memory_cross_attention(h, mem_n, w_mq, w_mk, w_mv, w_mo):
    B, S, _ = h.shape
    q = (h @ w_mq).reshape(B, S, MEM_HEADS, MEM_HEAD_DIM)
    k = (mem_n @ w_mk).reshape(B, MEM_TOKENS, MEM_HEADS, MEM_HEAD_DIM)
    v = (mem_n @ w_mv).reshape(B, MEM_TOKENS, MEM_HEADS, MEM_HEAD_DIM)
    s = jnp.einsum('bqhd,bmhd->bhqm', q, k).astype(jnp.float32) / math.sqrt(MEM_HEAD_DIM)
    p = jax.nn.softmax(s, axis=-1).astype(v.dtype)
    o = jnp.einsum('bhqm,bmhd->bqhd', p, v).reshape(B, S, MEM_WIDTH)
    return o @ w_mo


def conv_ffn(h, w_up, conv_w, conv_b, w_down):
    u = h @ w_up
    up = jnp.pad(u, ((0, 0), (1, 1), (0, 0)))
    S = h.shape[1]
    uc = (up[:, 0:S] * conv_w[0] + up[:, 1:S + 1] * conv_w[1]
          + up[:, 2:S + 2] * conv_w[2] + conv_b)
    g, val = uc[..., :D_FF], uc[..., D_FF:]
    return (jax.nn.gelu(g) * val) @ w_down


def setup_inputs(seed: int = 0) -> dict:
    key = jax.random.key(seed)
    ks = iter(jax.random.split(key, 64))
    L = DEPTH

    def nrm(shape, scale):
        return jax.random.normal(next(ks), shape, jnp.float32) * scale

    def gain(shape):
        return 1.0 + nrm(shape, 0.02)

    x = nrm((BATCH, SEQ, D_MODEL), 1.0)
    mem = nrm((BATCH, MEM_TOKENS, D_MODEL), 1.0)
    offs = jax.random.randint(next(ks), (BATCH, 1), 0, 1024, dtype=jnp.int32)
    positions = jnp.arange(SEQ, dtype=jnp.int32)[None, :] + offs
    return {
        "x": x,
        "mem": mem,
        "positions": positions,
        "mix_pre_norm": gain((L, D_MODEL)),
        "mix_post_norm": gain((L, D_MODEL)),
        "w_in": nrm((L, D_MODEL, N_IN), D_MODEL ** -0.5),
        "mla_q_norm": gain((L, Q_LORA)),
        "w_uq": nrm((L, Q_LORA, MLA_HEADS * (QK_NOPE + QK_ROPE)), Q_LORA ** -0.5),
        "mla_kv_norm": gain((L, KV_LORA)),
        "w_ukv": nrm((L, KV_LORA, MLA_HEADS * (QK_NOPE + V_DIM)), KV_LORA ** -0.5),
        "sg_norm": gain((L, SG_WIDTH)),
        "w_spatial": nrm((L, SG_GROUPS, CHUNK, CHUNK), CHUNK ** -0.5),
        "b_spatial": 1.0 + nrm((L, SG_GROUPS, CHUNK), 0.02),
        "w_br_f": nrm((L, F_WIDTH, D_MODEL), F_WIDTH ** -0.5),
        "w_br_a": nrm((L, MLA_WIDTH, D_MODEL), MLA_WIDTH ** -0.5),
        "w_br_s": nrm((L, SG_WIDTH, D_MODEL), SG_WIDTH ** -0.5),
        "w_gate": nrm((L, D_MODEL, N_BRANCH * D_MODEL), D_MODEL ** -0.5),
        "b_gate": nrm((L, N_BRANCH * D_MODEL), 0.02),
        "w_out": nrm((L, D_MODEL, D_MODEL), D_MODEL ** -0.5),
        "mem_pre_norm": gain((L, D_MODEL)),
        "mem_post_norm": gain((L, D_MODEL)),
        "mem_kv_norm": gain((L, D_MODEL)),
        "w_mq": nrm((L, D_MODEL, MEM_WIDTH), D_MODEL ** -0.5),
        "w_mk": nrm((L, D_MODEL, MEM_WIDTH), D_MODEL ** -0.5),
        "w_mv": nrm((L, D_MODEL, MEM_WIDTH), D_MODEL ** -0.5),
        "w_mo": nrm((L, MEM_WIDTH, D_MODEL), MEM_WIDTH ** -0.5),
        "ffn_pre_norm": gain((L, D_MODEL)),
        "ffn_post_norm": gain((L, D_MODEL)),
        "w_up": nrm((L, D_MODEL, 2 * D_FF), D_MODEL ** -0.5),
        "conv_w": nrm((L, CONV_WIDTH, 2 * D_FF), CONV_WIDTH ** -0.5),
        "conv_b": nrm((L, 2 * D_FF), 0.02),
        "w_down": nrm((L, D_FF, D_MODEL), D_FF ** -0.5),
    }


def reference(x, mem, positions, mix_pre_norm, mix_post_norm, w_in, mla_q_norm, w_uq,
              mla_kv_norm, w_ukv, sg_norm, w_spatial, b_spatial, w_br_f, w_br_a, w_br_s,
              w_gate, b_gate, w_out, mem_pre_norm, mem_post_norm, mem_kv_norm, w_mq, w_mk,
              w_mv, w_mo, ffn_pre_norm, ffn_post_norm, w_up, conv_w, conv_b, w_down):
    B, S, _ = x.shape
    inv_freq = ROPE_THETA ** (-jnp.arange(0, QK_ROPE, 2, dtype=jnp.float32) / QK_ROPE)
    ang = positions.astype(jnp.float32)[..., None] * inv_freq
    cos, sin = jnp.cos(ang), jnp.sin(ang)

    for l in range(DEPTH):
        h = rms_norm(x, mix_pre_norm[l])
        z = h @ w_in[l]
        y_f = fourier_branch(z[..., OFF_F:OFF_CQ]) @ w_br_f[l]
        y_a = mla_branch(z[..., OFF_CQ:OFF_CKV], z[..., OFF_CKV:OFF_KR],
                         z[..., OFF_KR:OFF_SG], cos, sin,
                         mla_q_norm[l], w_uq[l], mla_kv_norm[l], w_ukv[l]) @ w_br_a[l]
        y_s = spatial_gating_branch(z[..., OFF_SG:], sg_norm[l], w_spatial[l],
                                    b_spatial[l]) @ w_br_s[l]
        gates = jax.nn.sigmoid((h @ w_gate[l] + b_gate[l]).astype(jnp.float32))
        gates = gates.astype(x.dtype).reshape(B, S, N_BRANCH, D_MODEL)
        merged = gates[:, :, 0] * y_f + gates[:, :, 1] * y_a + gates[:, :, 2] * y_s
        x = x + rms_norm(merged @ w_out[l], mix_post_norm[l])

        h = rms_norm(x, mem_pre_norm[l])
        mem_n = rms_norm(mem, mem_kv_norm[l])
        y = memory_cross_attention(h, mem_n, w_mq[l], w_mk[l], w_mv[l], w_mo[l])
        x = x + rms_norm(y, mem_post_norm[l])

        h = rms_norm(x, ffn_pre_norm[l])
        y = conv_ffn(h, w_up[l], conv_w[l], conv_b[l], w_down[l])
        x = x + rms_norm(y, ffn_post_norm[l])
    return x
```

```cpp
#define MK_N_LAUNCHES 1
#include <hip/hip_runtime.h>
#include <cstdio>
#include <cstdint>
#include <cstring>

#ifndef MK_N_LAUNCHES
#define MK_N_LAUNCHES 1
#endif
#ifndef MK_DIGEST
#define MK_DIGEST 0
#endif
#ifndef MK_CHECK
#define MK_CHECK 0
#endif

#define LAS __attribute__((address_space(3)))
#define GAS __attribute__((address_space(1)))
typedef unsigned short bf16_t;
typedef short bf16x8 __attribute__((ext_vector_type(8)));
typedef short s16x4 __attribute__((ext_vector_type(4)));
typedef float f32x2 __attribute__((ext_vector_type(2)));
typedef float f32x4 __attribute__((ext_vector_type(4)));
typedef float f32x8 __attribute__((ext_vector_type(8)));
typedef float f32x16 __attribute__((ext_vector_type(16)));
typedef unsigned u32x2 __attribute__((ext_vector_type(2)));
typedef unsigned u32x4 __attribute__((ext_vector_type(4)));

constexpr int SEQ = 16384, DM = 4096, DEPTH = 2;
constexpr int F_WIDTH = 1024, Q_LORA = 768, KV_LORA = 512, QK_ROPE = 64, SG_WIDTH = 2048;
constexpr int N_IN = 6464, N_INP = 6656;
constexpr int ZC_F = 0, ZC_CQ = 1024, ZC_CKV = 1792, ZC_SGU = 2304, ZC_SGV = 4352, ZC_KR = 6400;
constexpr int N_GATE = 3 * DM, N_ING = N_INP + N_GATE;
#ifndef F_INT8
#define F_INT8 1
#endif
constexpr int N_ZB = F_INT8 ? 1536 : 2560;
constexpr int N_ZQ = F_INT8 ? 5120 : 4096, N_Q8 = N_ZQ + N_GATE;
constexpr int MLA_H = 8, QK_NOPE = 128, V_DIM = 128, DQK = 192;
constexpr int NQ = MLA_H * DQK  , NKV = MLA_H * (QK_NOPE + V_DIM)  ;
constexpr int MEM_T = 256, MEM_W = 1024;
constexpr int D_FF = 11008, N_UP = 2 * D_FF;
constexpr float EPS = 1e-6f;
constexpr float WG8_SCALE = 64.0f;

constexpr size_t MiB = 1u << 20;
constexpr size_t WS_CTL = 0, CTL_BYTES = 65536;
constexpr size_t WS_DRE = 1 * MiB, WS_DIM = WS_DRE + 131072, WS_F1 = WS_DIM + 131072, WS_F3 = WS_F1 + 131072;
constexpr size_t WS_TWC = WS_F3 + 131072, WS_TWS = WS_TWC + 65536;
constexpr size_t WS_ROPEC = 2 * MiB, WS_ROPES = 4 * MiB;
constexpr size_t WS_MEMN = 6 * MiB;
constexpr size_t WS_KMEM = 10 * MiB, WS_VMEMT = 11 * MiB;
constexpr size_t WS_SGW = 12 * MiB;
constexpr size_t WS_RSTD = 13 * MiB;
constexpr size_t WS_RSQ = WS_RSTD + 1 * MiB;
constexpr size_t WS_CS = WS_RSTD + 2 * MiB, CS_LAYER = 262144, CS_UP = 98304;
constexpr size_t WS_W = 17 * MiB, W_LAYER = 507 * MiB;
constexpr size_t WOI_Q8 = 24 * MiB;
constexpr size_t WO_ING = 0, WO_UQ = 148 * MiB, WO_UKV = WO_UQ + 2359296, WO_BRF = 153 * MiB, WO_BRA = 161 * MiB, WO_BRS = 169 * MiB,
                 WO_OUT = 185 * MiB, WO_MQ = 217 * MiB, WO_MK = 225 * MiB, WO_MV = 233 * MiB, WO_MO = 241 * MiB, WO_UP = 249 * MiB, WO_DOWN = 421 * MiB;
static_assert(WO_UKV + 2 * MiB <= WO_BRF && WO_DOWN + 86 * MiB <= W_LAYER, "weight map");
constexpr size_t WS_ACT = WS_W + 2 * W_LAYER;
constexpr size_t WS_H = WS_ACT, WS_Z = WS_H + 128 * MiB, WS_GATES = WS_Z + 208 * MiB, WS_WT1 = WS_GATES + 384 * MiB, WS_S1O = WS_WT1 + 64 * MiB,
                 WS_YF = WS_S1O + 64 * MiB, WS_Q = WS_YF + 32 * MiB, WS_KV = WS_Q + 48 * MiB, WS_OA = WS_KV + 64 * MiB, WS_SGO = WS_OA + 32 * MiB,
                 WS_MERGED = WS_SGO + 64 * MiB, WS_Y = WS_MERGED + 128 * MiB, WS_XB8 = WS_Y + 128 * MiB, WS_END = WS_XB8 + 65 * MiB;
constexpr size_t WS_QM = WS_Z, WS_PM = WS_Z + 32 * MiB, WS_OM = WS_Z + 64 * MiB;
constexpr size_t WS_U = WS_Z, WS_ACTV = WS_U + 688 * MiB;
static_assert(WS_ACTV + 344 * MiB <= WS_Y, "FFN overlay must not reach Y");
constexpr int CW_TMO = 0, CW_CODE = 1, CW_CHK = 64  , CW_BAR = 4096;

constexpr int RING_BYTES = 131072;
constexpr int EPX_OFF = RING_BYTES, EPX_BYTES = 8192;
constexpr int MISC_OFF = EPX_OFF + EPX_BYTES;
constexpr int LDS_BYTES = 147456;

#define RLX_AGENT __ATOMIC_RELAXED, __HIP_MEMORY_SCOPE_AGENT
#define LDS_WAIT() asm volatile("s_waitcnt lgkmcnt(0)" ::: "memory")
#define VM_WAIT() asm volatile("s_waitcnt vmcnt(0)" ::: "memory")
typedef __bf16 bf16v2_t __attribute__((ext_vector_type(2)));
__device__ __forceinline__ unsigned cvt_pk_bf16(float lo, float hi) { const f32x2 v = {lo, hi}; const bf16v2_t r = __builtin_convertvector(v, bf16v2_t); return __builtin_bit_cast(unsigned, r); }
__device__ __forceinline__ float bf2f(unsigned short b) { return __uint_as_float(((unsigned)b) << 16); }
__device__ __forceinline__ float bflo(unsigned w) { return __uint_as_float(w << 16); }
__device__ __forceinline__ float bfhi(unsigned w) { return __uint_as_float(w & 0xffff0000u); }
__device__ __forceinline__ unsigned short f2bf(float f) { return (unsigned short)(cvt_pk_bf16(f, 0.f) & 0xffffu); }
__device__ __forceinline__ float xshfl(int lane, float v, int mask) { return __int_as_float(__builtin_amdgcn_ds_bpermute((lane ^ mask) << 2, __float_as_int(v))); }
__device__ __forceinline__ float wave_sum(int lane, float v) {
#pragma unroll
    for (int o = 1; o < 64; o <<= 1) v += xshfl(lane, v, o);
    return v;
}
__device__ __forceinline__ float wave_max(int lane, float v) {
#pragma unroll
    for (int o = 1; o < 64; o <<= 1) v = fmaxf(v, xshfl(lane, v, o));
    return v;
}
__device__ __forceinline__ unsigned pack_i8x4(float a, float b, float c, float d) {
    const int ia = (int)__builtin_rintf(a), ib = (int)__builtin_rintf(b), ic = (int)__builtin_rintf(c), id = (int)__builtin_rintf(d);
    return ((unsigned)ia & 255u) | (((unsigned)ib & 255u) << 8) | (((unsigned)ic & 255u) << 16) | ((unsigned)id << 24);
}
__device__ __forceinline__ int otid() { int t = threadIdx.x; asm volatile("" : "+v"(t)); return t; }
template <class T> __device__ __forceinline__ T* optr(T* p) { asm volatile("" : "+s"(p)); return p; }
template <class T> __device__ __forceinline__ const __attribute__((address_space(4))) T* optr(const __attribute__((address_space(4))) T* p) { asm volatile("" : "+s"(p)); return p; }
__device__ __forceinline__ float gelu_tanh(float x) {
    const float u = x * (0.7978845608028654f + 0.035677408136300125f * x * x);
    const float e = __builtin_amdgcn_exp2f(-2.885390081777927f * u);
    return x * __builtin_amdgcn_rcpf(1.0f + e);
}
__device__ __forceinline__ float sigmoid_f(float x) { return __builtin_amdgcn_rcpf(1.0f + __builtin_amdgcn_exp2f(-1.4426950408889634f * x)); }

#define XB_TMO      128
#define XB_XCNT(j)  (256  + 64 * (j))
#define XB_XSUB(j)  (1280 + 64 * (j))
#define XB_XGEN(j)  (2304 + 64 * (j))
#define XB_TOP      3328
#define XB_TOPGEN   3392
#define XCD_BAR_WORDS 3456
#define XB_SPIN_CAP (1u << 22)
__device__ __forceinline__ unsigned xb_ld(unsigned* p)              { return __hip_atomic_load(p, __ATOMIC_RELAXED, __HIP_MEMORY_SCOPE_AGENT); }
__device__ __forceinline__ unsigned xb_add(unsigned* p, unsigned v) { return __hip_atomic_fetch_add(p, v, __ATOMIC_RELAXED, __HIP_MEMORY_SCOPE_AGENT); }
__device__ __forceinline__ unsigned xb_xcc_id() { return (unsigned)__builtin_amdgcn_s_getreg((3 << 11) | 20) & 0xFu; }
#define XB_SPIN(cond, bar) do { unsigned _sp = 0; while (cond) { __builtin_amdgcn_s_sleep(1); \
    if ((++_sp & 255u) == 0u) { if (xb_ld(&(bar)[XB_TMO])) break; if (_sp > XB_SPIN_CAP) { atomicAdd(&(bar)[XB_TMO], 1u); break; } } } } while (0)
struct XcdBarrier { unsigned* bar; unsigned x; volatile LAS unsigned* st; };
__device__ __forceinline__ XcdBarrier xcd_barrier_post(unsigned* bar, volatile LAS unsigned* st) {
    XcdBarrier b; b.bar = bar; b.x = xb_xcc_id(); b.st = st;
    if (threadIdx.x == 0) (void)xb_add(&bar[XB_XCNT(b.x)], 1u);
    return b;
}
__device__ __forceinline__ void xcd_barrier_complete(unsigned* bar, unsigned x, unsigned& nloc, unsigned& nx) {
    const unsigned G = gridDim.x * gridDim.y * gridDim.z;
    unsigned sum, cnt, mine, sp = 0u;
    for (;;) {
        sum = 0u; cnt = 0u; mine = 0u;
#pragma unroll
        for (unsigned j = 0; j < 16; ++j) { const unsigned c = xb_ld(&bar[XB_XCNT(j)]); sum += c; cnt += (c > 0u) ? 1u : 0u; mine = (j == x) ? c : mine; }
        if (sum == G) break;
        __builtin_amdgcn_s_sleep(1);
        if ((++sp & 255u) == 0u) { if (xb_ld(&bar[XB_TMO])) break; if (sp > XB_SPIN_CAP) { atomicAdd(&bar[XB_TMO], 1u); break; } }
    }
    nloc = mine > 0u ? mine : 1u; nx = cnt > 0u ? cnt : 1u;
}
__device__ __forceinline__ void xcd_barrier(const XcdBarrier& b) {
    asm volatile("s_waitcnt vmcnt(0)" ::: "memory");
    __syncthreads();
    if (threadIdx.x == 0) {
        unsigned* bar = b.bar;
        __builtin_amdgcn_s_waitcnt(0);
        unsigned nloc = b.st[0], nx = b.st[1];
        if (nloc == 0u) { xcd_barrier_complete(bar, b.x, nloc, nx); b.st[0] = nloc; b.st[1] = nx; }
        const unsigned old = xb_add(&bar[XB_XSUB(b.x)], 1u);
        const unsigned gen = old / nloc;
        if (old + 1u == (gen + 1u) * nloc) {
            __builtin_amdgcn_fence(__ATOMIC_RELEASE, "agent");
            asm volatile("s_waitcnt vmcnt(0)" ::: "memory");
            const unsigned og = xb_add(&bar[XB_TOP], 1u);
            const unsigned tg = og / nx;
            if (og + 1u == (tg + 1u) * nx) xb_add(&bar[XB_TOPGEN], 1u);
            else XB_SPIN(xb_ld(&bar[XB_TOPGEN]) == tg, bar);
            __builtin_amdgcn_fence(__ATOMIC_ACQUIRE, "agent");
            xb_add(&bar[XB_XGEN(b.x)], 1u);
            asm volatile("s_waitcnt vmcnt(0)" ::: "memory");
        } else {
            XB_SPIN(xb_ld(&bar[XB_XGEN(b.x)]) == gen, bar);
            __builtin_amdgcn_fence(__ATOMIC_ACQUIRE, "agent");
            asm volatile("s_waitcnt vmcnt(0)" ::: "memory");
        }
    }
    __syncthreads();
}

#ifndef PG8_SP2
#define PG8_SP2 1
#endif
namespace pg8 {
#ifndef PG8_WGM
#define PG8_WGM 4
#endif
constexpr int BM = 256, BK = 64, HALF = 128, HTB = HALF * BK * 2, STAGE_BYTES = 8 * HTB, NXCD = 8, WGM = PG8_WGM;
__host__ __device__ __forceinline__ int lds_byte(int r, int c) { const int st = (r >> 4) * 2 + (c >> 5), rr = r & 15, cc = c & 31, ob = rr * 64 + cc * 2; return st * 1024 + (ob ^ (((ob >> 9) & 1) << 5)); }
__host__ __device__ __forceinline__ void stage_rc(int b, int& R, int& C) { const int st = b / 1024, sb = b % 1024, swz = sb ^ (((sb >> 9) & 1) << 5); R = (st >> 1) * 16 + swz / 64; C = (st & 1) * 32 + (swz % 64) / 2; }
__host__ __device__ __forceinline__ int perm32(int rho) { const int n = rho >> 4, i = rho & 15; return 8 * (i >> 2) + 4 * n + (i & 3); }
struct Unit { int pm, pn; };
struct Gemm { const void* A; const void* B; size_t tsA, pnA, tsB, pmB; unsigned rsA, rsB; size_t hsA, hsB; int nM, nN, nt; };
__device__ __forceinline__ Gemm make_gemm(const bf16_t* A, int lda, const bf16_t* B, int ldb, int M, int N, int K) {
    Gemm g; g.A = A; g.B = B; g.tsA = (size_t)256 * lda * 2; g.pnA = 0; g.tsB = (size_t)256 * ldb * 2; g.pmB = 0; g.rsA = (unsigned)lda * 2u; g.rsB = (unsigned)ldb * 2u;
    g.hsA = (size_t)128 * lda * 2; g.hsB = (size_t)128 * ldb * 2; g.nM = M / 256; g.nN = N / 256; g.nt = K / 64; return g;
}
struct StaticOrder {
    int nM, nN, nwg, G, c;
    __device__ __forceinline__ void init(int nM_, int nN_, int G_, int c_) { nM = nM_; nN = nN_; nwg = nM * nN; G = G_; c = c_; }
    __device__ __forceinline__ bool unit_of(long L, Unit& u) const {
        if (L < 0 || L >= nwg) return false;
        int wgid = (int)L; { const int q = nwg / NXCD, r = nwg % NXCD, xcd = wgid % NXCD, off = wgid / NXCD; wgid = (xcd < r ? xcd * (q + 1) : r * (q + 1) + (xcd - r) * q) + off; }
        const int nig = WGM * nN, gid = wgid / nig, fm = gid * WGM, gsz = (nM - fm) < WGM ? (nM - fm) : WGM;
        u.pm = fm + ((wgid % nig) % gsz); u.pn = (wgid % nig) / gsz; return true;
    }
    __device__ __forceinline__ bool next(int i, Unit& u) const { return unit_of((long)i * G + c, u); }
};
struct GateOrder : StaticOrder {
    int mode, r0;
    __device__ __forceinline__ long deal(int i) const {
        const int H = G >> 1;
        if (mode == 1) { if (i < r0) return (long)i * G + c; if (c < H || i > r0 + 1) return -1; return (long)r0 * G + (long)(i - r0) * H + (c - H); }
        if (mode == 2) {
            if (i < r0) return (long)i * G + c;
            if (c >= H + 16) { if (i > r0 + 1) return -1; return (long)r0 * G + (long)(i - r0) * (H - 16) + (c - H - 16); }
            if (c < 32 && i == r0) return (long)r0 * G + (long)2 * (H - 16) + c;
            return -1; }
        return (long)i * G + c;
    }
    __device__ __forceinline__ bool next(int i, Unit& u) const { return unit_of(deal(i), u); }
};
typedef int i32x8 __attribute__((ext_vector_type(8)));
typedef int i32x4 __attribute__((ext_vector_type(4)));
__device__ __forceinline__ i32x8 cat8(const bf16x8 lo, const bf16x8 hi) { const u32x4 a = __builtin_bit_cast(u32x4, lo), b = __builtin_bit_cast(u32x4, hi); return (i32x8){(int)a.x, (int)a.y, (int)a.z, (int)a.w, (int)b.x, (int)b.y, (int)b.z, (int)b.w}; }
template <class Epi, int MODE = 0, class Sched = StaticOrder>
__device__ __forceinline__ void gemm_phase(LAS unsigned char* lds, const Gemm g, const Sched& S, const Epi& E) {
    constexpr bool FP8 = (MODE == 1), I8 = (MODE == 2);
    const int tid = otid(), wid = __builtin_amdgcn_readfirstlane(tid >> 6), lane = tid & 63, wr = wid >> 2, wc = wid & 3, fr = lane & 15, fq = lane >> 4;
    const int nt = g.nt;
    unsigned voffA[2], voffB[2];
#pragma unroll
    for (int i = 0; i < 2; ++i) { int R, C; stage_rc(tid * 16 + i * 8192, R, C); const int Rb = (R & ~31) + perm32(R & 31);
        voffA[i] = (unsigned)R * g.rsA + (unsigned)C * 2u; voffB[i] = (unsigned)Rb * g.rsB + (unsigned)C * 2u; }
    const size_t kstep = (size_t)(BK * 2);
    const size_t hsA = g.hsA, hsB = g.hsB;
    const unsigned ldsw = (unsigned)wid * 1024u;
    const int aoff = lds_byte(wr * 64 + fr, fq * 8), boff = lds_byte(wc * 32 + fr, fq * 8);
#define PG8_SA(b, h) (((b) * 2 + (h)) * HTB)
#define PG8_SB(b, h) ((4 + (b) * 2 + (h)) * HTB)
#define PG8_STAGE(bufoff, gbase, voff) do { _Pragma("unroll") for (int _i = 0; _i < 2; ++_i) \
        __builtin_amdgcn_global_load_lds((const unsigned*)((const char*)(gbase) + (voff)[_i]), (LAS unsigned*)(lds + (bufoff) + ldsw + _i * 8192), 16, 0, 0); } while (0)
#define PG8_LDA(dst, b, h) do { if constexpr (FP8) { _Pragma("unroll") for (int m = 0; m < 4; ++m) { const u32x4 lo_ = *(const LAS u32x4*)(lds + PG8_SA(b, h) + aoff + m * 2048), hi_ = *(const LAS u32x4*)(lds + PG8_SA(b, h) + aoff + m * 2048 + 1024); \
            dst##8[m] = __builtin_bit_cast(i32x8, __builtin_shufflevector(lo_, hi_, 0, 1, 2, 3, 4, 5, 6, 7)); } } \
        else { _Pragma("unroll") for (int m = 0; m < 4; ++m) _Pragma("unroll") for (int k = 0; k < 2; ++k) dst[m][k] = *(const LAS bf16x8*)(lds + PG8_SA(b, h) + aoff + m * 2048 + k * 1024); } } while (0)
#define PG8_LDB(dst, b, h) do { if constexpr (FP8) { _Pragma("unroll") for (int n = 0; n < 2; ++n) { const u32x4 lo_ = *(const LAS u32x4*)(lds + PG8_SB(b, h) + boff + n * 2048), hi_ = *(const LAS u32x4*)(lds + PG8_SB(b, h) + boff + n * 2048 + 1024); \
            dst##8[n] = __builtin_bit_cast(i32x8, __builtin_shufflevector(lo_, hi_, 0, 1, 2, 3, 4, 5, 6, 7)); } } \
        else { _Pragma("unroll") for (int n = 0; n < 2; ++n) _Pragma("unroll") for (int k = 0; k < 2; ++k) dst[n][k] = *(const LAS bf16x8*)(lds + PG8_SB(b, h) + boff + n * 2048 + k * 1024); } } while (0)
#define PG8_MMA(ai, bj, At, Bt) do { __builtin_amdgcn_s_setprio(1); \
        if constexpr (FP8) { _Pragma("unroll") for (int m = 0; m < 4; ++m) _Pragma("unroll") for (int n = 0; n < 2; ++n) \
            asm volatile("v_mfma_scale_f32_16x16x128_f8f6f4 %0, %1, %2, %0, %3, %3 op_sel_hi:[0,0,0]" : "+v"(acc[ai][bj][m][n]) : "v"(Bt##8[n]), "v"(At##8[m]), "v"(one_scale)); } \
        else if constexpr (I8) { _Pragma("unroll") for (int m = 0; m < 4; ++m) _Pragma("unroll") for (int n = 0; n < 2; ++n) _Pragma("unroll") for (int k = 0; k < 2; ++k) \
            acc[ai][bj][m][n] = __builtin_bit_cast(f32x4, __builtin_amdgcn_mfma_i32_16x16x64_i8(__builtin_bit_cast(i32x4, Bt[n][k]), __builtin_bit_cast(i32x4, At[m][k]), __builtin_bit_cast(i32x4, acc[ai][bj][m][n]), 0, 0, 0)); } \
        else { _Pragma("unroll") for (int m = 0; m < 4; ++m) _Pragma("unroll") for (int n = 0; n < 2; ++n) _Pragma("unroll") for (int k = 0; k < 2; ++k) \
            acc[ai][bj][m][n] = __builtin_amdgcn_mfma_f32_16x16x32_bf16(Bt[n][k], At[m][k], acc[ai][bj][m][n], 0, 0, 0); } \
        __builtin_amdgcn_s_setprio(0); } while (0)
#define PG8_WAIT_V(n) asm volatile("s_waitcnt vmcnt(" #n ")" ::: "memory")
#define PG8_WAIT_L(n) asm volatile("s_waitcnt lgkmcnt(" #n ")" ::: "memory")
#define PG8_BAR __builtin_amdgcn_s_barrier()
#define PG8_SCHED __builtin_amdgcn_sched_barrier(0)
    Unit cur, nxt; int ui = 0;
    if (!S.next(0, cur)) return;
    f32x4 acc[2][2][4][2];
#pragma unroll
    for (int a = 0; a < 2; ++a)
#pragma unroll
        for (int b = 0; b < 2; ++b)
#pragma unroll
            for (int m = 0; m < 4; ++m)
#pragma unroll
                for (int n = 0; n < 2; ++n) acc[a][b][m][n] = (f32x4){0.f, 0.f, 0.f, 0.f};
    int one_scale = 0x7F7F7F7F; asm volatile("" : "+v"(one_scale));
    bf16x8 At[4][2], B0[2][2], B1[2][2]; i32x8 At8[4], B08[2], B18[2]; (void)At; (void)B0; (void)B1; (void)At8; (void)B08; (void)B18;
    const char* cA = (const char*)g.A + (size_t)cur.pm * g.tsA + (size_t)cur.pn * g.pnA; const char* cB = (const char*)g.B + (size_t)cur.pn * g.tsB + (size_t)cur.pm * g.pmB;
#if PG8_SP2
    PG8_STAGE(PG8_SB(0, 0), cB, voffB); PG8_STAGE(PG8_SB(0, 1), cB + hsB, voffB); PG8_STAGE(PG8_SA(0, 0), cA, voffA); PG8_STAGE(PG8_SA(0, 1), cA + hsA, voffA);
    if (wr == 1) PG8_BAR;
    PG8_WAIT_V(2); PG8_BAR;
    PG8_STAGE(PG8_SB(1, 0), cB + kstep, voffB); PG8_STAGE(PG8_SA(1, 0), cA + kstep, voffA); PG8_STAGE(PG8_SB(1, 1), cB + hsB + kstep, voffB);
    PG8_WAIT_V(6); PG8_BAR;
#else
    PG8_STAGE(PG8_SB(0, 0), cB, voffB); PG8_STAGE(PG8_SA(0, 0), cA, voffA); PG8_STAGE(PG8_SB(0, 1), cB + hsB, voffB); PG8_STAGE(PG8_SA(0, 1), cA + hsA, voffA);
    if (wr == 1) PG8_BAR;
    PG8_WAIT_V(4); PG8_BAR;
    PG8_STAGE(PG8_SB(1, 0), cB + kstep, voffB); PG8_STAGE(PG8_SA(1, 0), cA + kstep, voffA); PG8_STAGE(PG8_SB(1, 1), cB + hsB + kstep, voffB);
    PG8_WAIT_V(6); PG8_BAR;
#endif
    for (;;) {
        const bool has_next = S.next(ui + 1, nxt);
        const char* nA = has_next ? (const char*)g.A + (size_t)nxt.pm * g.tsA + (size_t)nxt.pn * g.pnA : cA;
        const char* nB = has_next ? (const char*)g.B + (size_t)nxt.pn * g.tsB + (size_t)nxt.pm * g.pmB : cB;
        for (int t = 0; t < nt; t += 2) {
            const bool last = (t == nt - 2);
            const char* a1 = cA + (size_t)(t + 1) * kstep;
            const char* a2 = last ? nA : cA + (size_t)(t + 2) * kstep; const char* b2 = last ? nB : cB + (size_t)(t + 2) * kstep;
            const char* a3 = a2 + kstep; const char* b3 = b2 + kstep;
#if PG8_SP2
            PG8_LDB(B0, 0, 0); PG8_LDB(B1, 0, 1); PG8_SCHED; PG8_LDA(At, 0, 0); PG8_STAGE(PG8_SA(1, 1), a1 + hsA, voffA);
            PG8_WAIT_V(8); PG8_WAIT_L(0); PG8_BAR; PG8_MMA(0, 0, At, B0); PG8_MMA(0, 1, At, B1); PG8_BAR; PG8_SCHED;
            PG8_LDA(At, 0, 1); PG8_STAGE(PG8_SB(0, 0), b2, voffB); PG8_STAGE(PG8_SB(0, 1), b2 + hsB, voffB); PG8_STAGE(PG8_SA(0, 0), a2, voffA);
            PG8_WAIT_V(8); PG8_WAIT_L(0); PG8_BAR; PG8_MMA(1, 0, At, B0); PG8_MMA(1, 1, At, B1); PG8_BAR; PG8_SCHED;
            PG8_LDB(B0, 1, 0); PG8_LDB(B1, 1, 1); PG8_SCHED; PG8_LDA(At, 1, 0); PG8_STAGE(PG8_SA(0, 1), a2 + hsA, voffA);
            PG8_WAIT_V(8); PG8_WAIT_L(0); PG8_BAR; PG8_MMA(0, 0, At, B0); PG8_MMA(0, 1, At, B1); PG8_BAR; PG8_SCHED;
            PG8_LDA(At, 1, 1); PG8_STAGE(PG8_SB(1, 0), b3, voffB); PG8_STAGE(PG8_SB(1, 1), b3 + hsB, voffB); PG8_STAGE(PG8_SA(1, 0), a3, voffA);
            PG8_WAIT_V(8); PG8_WAIT_L(0); PG8_BAR; PG8_MMA(1, 0, At, B0); PG8_MMA(1, 1, At, B1); PG8_BAR; PG8_SCHED;
#else
            PG8_LDB(B0, 0, 0); PG8_SCHED; PG8_LDA(At, 0, 0); PG8_STAGE(PG8_SA(1, 1), a1 + hsA, voffA);
            PG8_WAIT_L(8); PG8_BAR; PG8_WAIT_L(0); PG8_MMA(0, 0, At, B0); PG8_BAR; PG8_SCHED;
            PG8_LDB(B1, 0, 1); PG8_STAGE(PG8_SB(0, 0), b2, voffB);
            PG8_BAR; PG8_WAIT_L(0); PG8_MMA(0, 1, At, B1); PG8_BAR;
            PG8_LDA(At, 0, 1); PG8_STAGE(PG8_SA(0, 0), a2, voffA);
            PG8_BAR; PG8_WAIT_L(0); PG8_MMA(1, 0, At, B0); PG8_BAR; PG8_SCHED;
            PG8_STAGE(PG8_SB(0, 1), b2 + hsB, voffB);
            PG8_WAIT_V(6); PG8_BAR; PG8_MMA(1, 1, At, B1); PG8_BAR;
            PG8_LDB(B0, 1, 0); PG8_SCHED; PG8_LDA(At, 1, 0); PG8_STAGE(PG8_SA(0, 1), a2 + hsA, voffA);
            PG8_WAIT_L(8); PG8_BAR; PG8_WAIT_L(0); PG8_MMA(0, 0, At, B0); PG8_BAR; PG8_SCHED;
            PG8_LDB(B1, 1, 1); PG8_STAGE(PG8_SB(1, 0), b3, voffB);
            PG8_BAR; PG8_WAIT_L(0); PG8_MMA(0, 1, At, B1); PG8_BAR;
            PG8_LDA(At, 1, 1); PG8_STAGE(PG8_SA(1, 0), a3, voffA);
            PG8_BAR; PG8_WAIT_L(0); PG8_MMA(1, 0, At, B0); PG8_BAR; PG8_SCHED;
            PG8_STAGE(PG8_SB(1, 1), b3 + hsB, voffB);
            PG8_WAIT_V(6); PG8_BAR; PG8_MMA(1, 1, At, B1); PG8_BAR;
#endif
        }
        if (wr == 0) PG8_BAR;
        if constexpr (FP8) asm volatile("s_nop 15\n\ts_nop 15" ::: "memory");
        if constexpr (I8) {
#pragma unroll
            for (int a = 0; a < 2; ++a)
#pragma unroll
                for (int b = 0; b < 2; ++b)
#pragma unroll
                    for (int m = 0; m < 4; ++m)
#pragma unroll
                        for (int n = 0; n < 2; ++n) acc[a][b][m][n] = __builtin_convertvector(__builtin_bit_cast(i32x4, acc[a][b][m][n]), f32x4);
        }
        E(acc, cur, wr, wc, fr, fq);
        if (!has_next) break;
#pragma unroll
        for (int a = 0; a < 2; ++a)
#pragma unroll
            for (int b = 0; b < 2; ++b)
#pragma unroll
                for (int m = 0; m < 4; ++m)
#pragma unroll
                    for (int n = 0; n < 2; ++n) acc[a][b][m][n] = (f32x4){0.f, 0.f, 0.f, 0.f};
        cur = nxt; cA = nA; cB = nB; ++ui;
        if (wr == 1) PG8_BAR;
    }
    PG8_WAIT_V(0);
    PG8_BAR;
#undef PG8_SA
#undef PG8_SB
#undef PG8_STAGE
#undef PG8_LDA
#undef PG8_LDB
#undef PG8_MMA
#undef PG8_WAIT_V
#undef PG8_WAIT_L
#undef PG8_BAR
#undef PG8_SCHED
}
}
#ifndef PROBE_DOUBLE_STORE
#define PROBE_DOUBLE_STORE 0
#endif
namespace pg8 {
__device__ __forceinline__ u32x4 pack8(const f32x4 v0, const f32x4 v1) {
    u32x4 w; w.x = cvt_pk_bf16(v0[0], v0[1]); w.y = cvt_pk_bf16(v0[2], v0[3]); w.z = cvt_pk_bf16(v1[0], v1[1]); w.w = cvt_pk_bf16(v1[2], v1[3]); return w;
}
struct EpiStore {
    bf16_t* O; int ldc; size_t tsO, pnO; const float* rs;
    __device__ __forceinline__ void operator()(const f32x4 (&acc)[2][2][4][2], const Unit& u, int wr, int wc, int fr, int fq) const {
        asm volatile("" : "+v"(fr), "+v"(fq));
        bf16_t* base = O + (size_t)u.pm * tsO + (size_t)u.pn * pnO + (size_t)(wr * 64 + fr) * ldc + wc * 32 + 8 * fq;
#pragma unroll
        for (int ai = 0; ai < 2; ++ai)
#pragma unroll
            for (int m = 0; m < 4; ++m) { bf16_t* rowp = base + (size_t)(ai * HALF + m * 16) * ldc;
                const float sc = rs ? rs[u.pm * BM + ai * HALF + wr * 64 + m * 16 + fr] : 1.0f;
#pragma unroll
                for (int bj = 0; bj < 2; ++bj) { const u32x4 w_ = pack8(acc[ai][bj][m][0] * sc, acc[ai][bj][m][1] * sc); *(u32x4*)(rowp + bj * HALF) = w_;
#if PROBE_DOUBLE_STORE
                    asm volatile("" ::: "memory"); *(u32x4*)(rowp + bj * HALF) = w_;
#endif
                } }
    }
};
struct EpiZB {
    bf16_t* Z; const float* rs;
    __device__ __forceinline__ void operator()(const f32x4 (&acc)[2][2][4][2], const Unit& u, int wr, int wc, int fr, int fq) const {
        asm volatile("" : "+v"(fr), "+v"(fq));
        const int row0 = u.pm * BM + wr * 64 + fr;
        bf16_t* base = Z + (size_t)row0 * N_INP + (u.pn < N_ZB / BM - 1 ? (F_INT8 ? ZC_CQ : 0) + u.pn * BM : ZC_KR) + wc * 32 + 8 * fq;
#pragma unroll
        for (int ai = 0; ai < 2; ++ai)
#pragma unroll
            for (int m = 0; m < 4; ++m) { bf16_t* rowp = base + (size_t)(ai * HALF + m * 16) * N_INP; const float sc = rs[row0 + ai * HALF + m * 16];
#pragma unroll
                for (int bj = 0; bj < 2; ++bj) *(u32x4*)(rowp + bj * HALF) = pack8(acc[ai][bj][m][0] * sc, acc[ai][bj][m][1] * sc); }
    }
};
struct EpiInQ {
    bf16_t* Z; bf16_t* G; const float* bgate; const float* rs; const float* cs;
    __device__ __forceinline__ void operator()(const f32x4 (&acc)[2][2][4][2], const Unit& u, int wr, int wc, int fr, int fq) const {
        asm volatile("" : "+v"(fr), "+v"(fq));
        const int row0 = u.pm * BM + wr * 64 + fr, cl = wc * 32 + 8 * fq;
        f32x4 cv[2][2];
#pragma unroll
        for (int bj = 0; bj < 2; ++bj)
#pragma unroll
            for (int n = 0; n < 2; ++n) cv[bj][n] = *(const f32x4*)(cs + u.pn * BM + cl + bj * HALF + 4 * n);
        constexpr int NF = F_INT8 ? 4 : 0;
        if (u.pn < NF + 16) {
            const bool act = u.pn >= NF;
            bf16_t* base = Z + (size_t)row0 * N_INP + (act ? ZC_SGU + (u.pn - NF) * BM : u.pn * BM) + cl;
#pragma unroll
            for (int ai = 0; ai < 2; ++ai)
#pragma unroll
                for (int m = 0; m < 4; ++m) { bf16_t* rowp = base + (size_t)(ai * HALF + m * 16) * N_INP; const float sc = rs[row0 + ai * HALF + m * 16];
#pragma unroll
                    for (int bj = 0; bj < 2; ++bj) { f32x4 v0 = (acc[ai][bj][m][0] * sc) * cv[bj][0], v1 = (acc[ai][bj][m][1] * sc) * cv[bj][1];
                        if (act) {
#pragma unroll
                            for (int j = 0; j < 4; ++j) { v0[j] = gelu_tanh(v0[j]); v1[j] = gelu_tanh(v1[j]); } }
                        *(u32x4*)(rowp + bj * HALF) = pack8(v0, v1); } }
        } else {
            const int gc = (u.pn - NF - 16) * BM + cl;
            bf16_t* base = G + (size_t)row0 * N_GATE + gc;
            f32x4 bv[2][2];
#pragma unroll
            for (int bj = 0; bj < 2; ++bj)
#pragma unroll
                for (int n = 0; n < 2; ++n) bv[bj][n] = *(const f32x4*)(bgate + gc + bj * HALF + 4 * n);
#pragma unroll
            for (int ai = 0; ai < 2; ++ai)
#pragma unroll
                for (int m = 0; m < 4; ++m) { bf16_t* rowp = base + (size_t)(ai * HALF + m * 16) * N_GATE; const float sc = rs[row0 + ai * HALF + m * 16];
#pragma unroll
                    for (int bj = 0; bj < 2; ++bj) { f32x4 v0 = (acc[ai][bj][m][0] * sc) * cv[bj][0] + bv[bj][0], v1 = (acc[ai][bj][m][1] * sc) * cv[bj][1] + bv[bj][1];
#pragma unroll
                        for (int j = 0; j < 4; ++j) { v0[j] = sigmoid_f(v0[j]); v1[j] = sigmoid_f(v1[j]); }
                        *(u32x4*)(rowp + bj * HALF) = pack8(v0, v1); } }
        }
    }
};
struct EpiMerge {
    bf16_t* M; const bf16_t* G; int first;
    __device__ __forceinline__ void operator()(const f32x4 (&acc)[2][2][4][2], const Unit& u, int wr, int wc, int fr, int fq) const {
        asm volatile("" : "+v"(fr), "+v"(fq));
        const int row0 = u.pm * BM + wr * 64 + fr, col0 = u.pn * BM + wc * 32 + 8 * fq;
#pragma unroll
        for (int ai = 0; ai < 2; ++ai) {
            u32x4 gw[4][2], pw[4][2];
#pragma unroll
            for (int m = 0; m < 4; ++m)
#pragma unroll
                for (int bj = 0; bj < 2; ++bj) { const size_t r = (size_t)(row0 + ai * HALF + m * 16);
                    gw[m][bj] = *(const u32x4*)(G + r * N_GATE + col0 + bj * HALF);
                    pw[m][bj] = (u32x4){0u, 0u, 0u, 0u}; if (!first) pw[m][bj] = *(const u32x4*)(M + r * DM + col0 + bj * HALF); }
#pragma unroll
            for (int m = 0; m < 4; ++m)
#pragma unroll
                for (int bj = 0; bj < 2; ++bj) { const size_t r = (size_t)(row0 + ai * HALF + m * 16); const u32x4 g = gw[m][bj], p = pw[m][bj];
                    f32x4 v0 = acc[ai][bj][m][0], v1 = acc[ai][bj][m][1];
                    v0[0] = bflo(p.x) + bflo(g.x) * v0[0]; v0[1] = bfhi(p.x) + bfhi(g.x) * v0[1]; v0[2] = bflo(p.y) + bflo(g.y) * v0[2]; v0[3] = bfhi(p.y) + bfhi(g.y) * v0[3];
                    v1[0] = bflo(p.z) + bflo(g.z) * v1[0]; v1[1] = bfhi(p.z) + bfhi(g.z) * v1[1]; v1[2] = bflo(p.w) + bflo(g.w) * v1[2]; v1[3] = bfhi(p.w) + bfhi(g.w) * v1[3];
                    *(u32x4*)(M + r * DM + col0 + bj * HALF) = pack8(v0, v1); }
            asm volatile("" ::: "memory");
        }
    }
};
struct EpiCD {
    bf16_t* WT1; int ri;
    __device__ __forceinline__ void operator()(const f32x4 (&acc)[2][2][4][2], const Unit& u, int wr, int wc, int fr, int fq) const {
        asm volatile("" : "+v"(fr), "+v"(fq));
#pragma unroll
        for (int ai = 0; ai < 2; ++ai)
#pragma unroll
            for (int m = 0; m < 4; ++m) { const int c = u.pm * 256 + ai * HALF + wr * 64 + m * 16 + fr;
#pragma unroll
                for (int bj = 0; bj < 2; ++bj) { const int b = 2 * u.pn + bj, a = wc * 32 + 8 * fq;
                    *(u32x4*)(WT1 + ((size_t)(c * 128 + b) * 2 + ri) * 128 + a) = pack8(acc[ai][bj][m][0], acc[ai][bj][m][1]); } }
    }
};
struct EpiS1 {
    bf16_t* S1O; const float* twc; const float* tws;
    __device__ __forceinline__ void operator()(const f32x4 (&acc)[2][2][4][2], const Unit& u, int wr, int wc, int fr, int fq) const {
        asm volatile("" : "+v"(fr), "+v"(fq));
#pragma unroll
        for (int m = 0; m < 4; ++m) { const int k2 = wr * 64 + m * 16 + fr, b0 = wc * 32 + 8 * fq;
            const f32x4 c0 = *(const f32x4*)(twc + k2 * 128 + b0), c1 = *(const f32x4*)(twc + k2 * 128 + b0 + 4), s0 = *(const f32x4*)(tws + k2 * 128 + b0), s1 = *(const f32x4*)(tws + k2 * 128 + b0 + 4);
#pragma unroll
            for (int bj = 0; bj < 2; ++bj) { const int c = 2 * u.pn + bj;
                const f32x4 re0 = acc[0][bj][m][0], re1 = acc[0][bj][m][1], im0 = acc[1][bj][m][0], im1 = acc[1][bj][m][1];
                const f32x4 ar0 = re0 * c0 + im0 * s0, ar1 = re1 * c1 + im1 * s1, ai0 = im0 * c0 - re0 * s0, ai1 = im1 * c1 - re1 * s1;
                bf16_t* p = S1O + ((size_t)(k2 * 1024 + c) * 2) * 128 + b0;
                *(u32x4*)p = pack8(ar0, ar1); *(u32x4*)(p + 128) = pack8(ai0, ai1); }
            asm volatile("" ::: "memory"); }
    }
};
struct EpiS3 {
    bf16_t* YF;
    __device__ __forceinline__ void operator()(const f32x4 (&acc)[2][2][4][2], const Unit& u, int wr, int wc, int fr, int fq) const {
        asm volatile("" : "+v"(fr), "+v"(fq));
        const int k2 = u.pn >> 2, c0 = (u.pn & 3) * 256 + wc * 32 + 8 * fq;
#pragma unroll
        for (int m = 0; m < 4; ++m) { const int k1 = wr * 64 + m * 16 + fr; bf16_t* rowp = YF + (size_t)(128 * k1 + k2) * 1024 + c0;
#pragma unroll
            for (int bj = 0; bj < 2; ++bj) *(u32x4*)(rowp + bj * HALF) = pack8(acc[0][bj][m][0], acc[0][bj][m][1]); }
    }
};
struct EpiSoftmax {
    bf16_t* P; LAS float* ex;
    __device__ __forceinline__ void operator()(const f32x4 (&acc)[2][2][4][2], const Unit& u, int wr, int wc, int fr, int fq) const {
        asm volatile("" : "+v"(fr), "+v"(fq));
        constexpr float C = 0.0625f * 1.4426950408889634f;
        float mx[2][4];
#pragma unroll
        for (int ai = 0; ai < 2; ++ai)
#pragma unroll
            for (int m = 0; m < 4; ++m) { float v = -3.0e38f;
#pragma unroll
                for (int bj = 0; bj < 2; ++bj)
#pragma unroll
                    for (int n = 0; n < 2; ++n) { const f32x4 x = acc[ai][bj][m][n]; v = fmaxf(v, fmaxf(fmaxf(x[0], x[1]), fmaxf(x[2], x[3]))); }
                v = fmaxf(v, xshfl(fr + 16 * fq, v, 16)); v = fmaxf(v, xshfl(fr + 16 * fq, v, 32));
                if (fq == 0) ex[(ai * HALF + wr * 64 + m * 16 + fr) * 4 + wc] = v; }
        LDS_WAIT(); __builtin_amdgcn_s_barrier(); asm volatile("" ::: "memory");
#pragma unroll
        for (int ai = 0; ai < 2; ++ai)
#pragma unroll
            for (int m = 0; m < 4; ++m) { const f32x4 t = *(const LAS f32x4*)(ex + (ai * HALF + wr * 64 + m * 16 + fr) * 4);
                const float M = fmaxf(fmaxf(t[0], t[1]), fmaxf(t[2], t[3])), mC = -M * C; float s = 0.f;
#pragma unroll
                for (int bj = 0; bj < 2; ++bj)
#pragma unroll
                    for (int n = 0; n < 2; ++n)
#pragma unroll
                        for (int j = 0; j < 4; ++j) s += __builtin_amdgcn_exp2f(fmaf(acc[ai][bj][m][n][j], C, mC));
                s += xshfl(fr + 16 * fq, s, 16); s += xshfl(fr + 16 * fq, s, 32);
                if (fq == 0) ex[1024 + (ai * HALF + wr * 64 + m * 16 + fr) * 4 + wc] = s; asm volatile("" ::: "memory"); }
        LDS_WAIT(); __builtin_amdgcn_s_barrier(); asm volatile("" ::: "memory");
        bf16_t* base = P + (size_t)(u.pm * BM + wr * 64 + fr) * MEM_W + u.pn * BM + wc * 32 + 8 * fq;
#pragma unroll
        for (int ai = 0; ai < 2; ++ai)
#pragma unroll
            for (int m = 0; m < 4; ++m) { const int rr = (ai * HALF + wr * 64 + m * 16 + fr) * 4;
                const f32x4 t = *(const LAS f32x4*)(ex + rr), ts = *(const LAS f32x4*)(ex + 1024 + rr);
                const float M = fmaxf(fmaxf(t[0], t[1]), fmaxf(t[2], t[3])), mC = -M * C;
                const float inv = __builtin_amdgcn_rcpf((ts[0] + ts[1]) + (ts[2] + ts[3])); bf16_t* rowp = base + (size_t)(ai * HALF + m * 16) * MEM_W;
#pragma unroll
                for (int bj = 0; bj < 2; ++bj) { f32x4 v0, v1;
#pragma unroll
                    for (int j = 0; j < 4; ++j) { v0[j] = __builtin_amdgcn_exp2f(fmaf(acc[ai][bj][m][0][j], C, mC)) * inv; v1[j] = __builtin_amdgcn_exp2f(fmaf(acc[ai][bj][m][1][j], C, mC)) * inv; }
                    *(u32x4*)(rowp + bj * HALF) = pack8(v0, v1); }
                asm volatile("" ::: "memory"); }
    }
};
struct EpiUpConv {
    bf16_t* ACT; const float* cw; const float* cb; const float* rs; const float* cs; LAS float* ex; int pn0;
    static __device__ __forceinline__ float dshr1(float old, float src) { return __int_as_float(__builtin_amdgcn_update_dpp(__float_as_int(old), __float_as_int(src), 0x111, 0xf, 0xf, false)); }
    static __device__ __forceinline__ float dshl1(float old, float src) { return __int_as_float(__builtin_amdgcn_update_dpp(__float_as_int(old), __float_as_int(src), 0x101, 0xf, 0xf, false)); }
    static __device__ __forceinline__ float dror1(float src)  { return __int_as_float(__builtin_amdgcn_mov_dpp(__float_as_int(src), 0x121, 0xf, 0xf, true)); }
    static __device__ __forceinline__ float dror15(float src) { return __int_as_float(__builtin_amdgcn_mov_dpp(__float_as_int(src), 0x12F, 0xf, 0xf, true)); }
    __device__ __forceinline__ void operator()(f32x4 (&acc)[2][2][4][2], const Unit& u, int wr, int wc, int fr, int fq) const {
        asm volatile("" : "+v"(fr), "+v"(fq));
        const int r0 = 254 * u.pm - 1;
        const int ecol = wc * 32 + 8 * fq;
        float scl[2][4]; bool okr[2][4];
#pragma unroll
        for (int ai = 0; ai < 2; ++ai)
#pragma unroll
            for (int m = 0; m < 4; ++m) { const int gr = r0 + ai * HALF + wr * 64 + m * 16 + fr; okr[ai][m] = gr >= 0 && gr < SEQ; scl[ai][m] = rs[okr[ai][m] ? gr : 0]; }
#pragma unroll
        for (int ai = 0; ai < 2; ++ai)
#pragma unroll
            for (int m = 0; m < 4; ++m) { const bool ok = okr[ai][m]; const float sc = scl[ai][m];
                if (u.pm > 0 && u.pm < 64) {
#pragma unroll
                    for (int bj = 0; bj < 2; ++bj)
#pragma unroll
                        for (int n = 0; n < 2; ++n) acc[ai][bj][m][n] = acc[ai][bj][m][n] * sc;
                } else {
#pragma unroll
                    for (int bj = 0; bj < 2; ++bj)
#pragma unroll
                        for (int n = 0; n < 2; ++n)
#pragma unroll
                            for (int j = 0; j < 4; ++j) acc[ai][bj][m][n][j] = ok ? acc[ai][bj][m][n][j] * sc : 0.f; } }
#pragma unroll
        for (int ai = 0; ai < 2; ++ai)
#pragma unroll
            for (int bj = 0; bj < 2; ++bj)
#pragma unroll
                for (int n = 0; n < 2; ++n) {
                    if (fr == 0)  *(LAS f32x4*)(ex + ((((wr * 2 + ai) * 2 + 0) * 2 + bj) * 128) + ecol + 4 * n) = acc[ai][bj][0][n];
                    if (fr == 15) *(LAS f32x4*)(ex + ((((wr * 2 + ai) * 2 + 1) * 2 + bj) * 128) + ecol + 4 * n) = acc[ai][bj][3][n]; }
        LDS_WAIT(); __builtin_amdgcn_s_barrier(); asm volatile("" ::: "memory");
#pragma unroll
        for (int n = 0; n < 2; ++n) {
            const int c0 = (u.pn + pn0) * 128 + ecol + 4 * n;
            const f32x4 csg = *(const f32x4*)(cs + (u.pn + pn0) * 256 + ecol + 4 * n), csv = *(const f32x4*)(cs + (u.pn + pn0) * 256 + 128 + ecol + 4 * n);
            const f32x4 wg0 = *(const f32x4*)(cw + c0) * csg, wg1 = *(const f32x4*)(cw + N_UP + c0) * csg, wg2 = *(const f32x4*)(cw + 2 * N_UP + c0) * csg, bg = *(const f32x4*)(cb + c0);
            const f32x4 wv0 = *(const f32x4*)(cw + D_FF + c0) * csv, wv1 = *(const f32x4*)(cw + N_UP + D_FF + c0) * csv, wv2 = *(const f32x4*)(cw + 2 * N_UP + D_FF + c0) * csv, bv = *(const f32x4*)(cb + D_FF + c0);
#pragma unroll
            for (int ai = 0; ai < 2; ++ai) {
                const f32x4 z4 = (f32x4){0.f, 0.f, 0.f, 0.f};
                f32x4 tg = z4, tv = z4, xg = z4, xv = z4;
                if (wr == 1 || ai == 1) { const int swr = wr == 1 ? 0 : 1, sai = wr == 1 ? ai : 0;
                    tg = *(const LAS f32x4*)(ex + ((((swr * 2 + sai) * 2 + 1) * 2 + 0) * 128) + ecol + 4 * n); tv = *(const LAS f32x4*)(ex + ((((swr * 2 + sai) * 2 + 1) * 2 + 1) * 128) + ecol + 4 * n); }
                if (wr == 0 || ai == 0) { const int swr = wr == 0 ? 1 : 0, sai = wr == 0 ? ai : 1;
                    xg = *(const LAS f32x4*)(ex + ((((swr * 2 + sai) * 2 + 0) * 2 + 0) * 128) + ecol + 4 * n); xv = *(const LAS f32x4*)(ex + ((((swr * 2 + sai) * 2 + 0) * 2 + 1) * 128) + ecol + 4 * n); }
#pragma unroll
                for (int m = 0; m < 4; ++m) {
                    float o[4];
#pragma unroll
                    for (int j = 0; j < 4; ++j) {
                        const float cg = acc[ai][0][m][n][j], cv = acc[ai][1][m][n][j];
                        const float pg = m > 0 ? dror1(acc[ai][0][m > 0 ? m - 1 : 0][n][j]) : tg[j], pv = m > 0 ? dror1(acc[ai][1][m > 0 ? m - 1 : 0][n][j]) : tv[j];
                        const float ng = m < 3 ? dror15(acc[ai][0][m < 3 ? m + 1 : 3][n][j]) : xg[j], nv = m < 3 ? dror15(acc[ai][1][m < 3 ? m + 1 : 3][n][j]) : xv[j];
                        const float ug = dshr1(pg, cg), uv = dshr1(pv, cv), dg = dshl1(ng, cg), dv = dshl1(nv, cv);
                        const float gc = fmaf(wg0[j], ug, fmaf(wg1[j], cg, fmaf(wg2[j], dg, bg[j])));
                        const float vc = fmaf(wv0[j], uv, fmaf(wv1[j], cv, fmaf(wv2[j], dv, bv[j])));
                        o[j] = gelu_tanh(gc) * vc; }
                    const int r = ai * HALF + wr * 64 + m * 16 + fr, gr = r0 + r;
                    if (r >= 1 && r <= 254 && gr < SEQ) { u32x2 w; w.x = cvt_pk_bf16(o[0], o[1]); w.y = cvt_pk_bf16(o[2], o[3]); *(u32x2*)(ACT + (size_t)gr * D_FF + c0) = w; }
                }
            }
        }
    }
};
}
struct Frame { LAS unsigned char* lds; int tid, lane, wave, G, bid; };
__device__ __forceinline__ Frame make_frame(LAS unsigned char* lds) { Frame F; F.lds = lds; F.tid = otid(); F.lane = F.tid & 63; F.wave = __builtin_amdgcn_readfirstlane(F.tid >> 6); F.G = gridDim.x; F.bid = blockIdx.x; return F; }
struct TrJob { const float* src; bf16_t* dst; const float* gain; float* cs; int K, pitch, n0, ncols, mode, pad; };
constexpr int NJOBS = 34;
struct Args {
    const float* in[32]; float* out; unsigned char* ws;
    TrJob jobs[NJOBS];
    int ph_lo, ph_hi; int pad0, pad1;
};

__device__ __forceinline__ void norm_rows(const Frame& F, const float* X, const float* gain, bf16_t* H, int nrows) {
    for (int m = F.bid * 8 + F.wave; m < nrows; m += F.G * 8) {
        const f32x4* xr = (const f32x4*)(X + (size_t)m * DM) + F.lane;
        f32x4 v[16]; float ss = 0.f;
#pragma unroll
        for (int j = 0; j < 16; ++j) { v[j] = xr[64 * j]; ss += (v[j][0] * v[j][0] + v[j][1] * v[j][1]) + (v[j][2] * v[j][2] + v[j][3] * v[j][3]); }
        const float rstd = rsqrtf(wave_sum(F.lane, ss) * (1.0f / DM) + EPS);
        u32x2* o = (u32x2*)(H + (size_t)m * DM) + F.lane;
#pragma unroll
        for (int j = 0; j < 16; ++j) { const f32x4 g = ((const f32x4*)gain)[64 * j + F.lane]; const f32x4 y = v[j] * rstd * g;
            u32x2 w; w.x = cvt_pk_bf16(y[0], y[1]); w.y = cvt_pk_bf16(y[2], y[3]); o[64 * j] = w; }
    }
}
__device__ __forceinline__ unsigned pack_fp8x4(float a, float b, float c, float d) { int w = 0; w = __builtin_amdgcn_cvt_pk_fp8_f32(a, b, w, false); w = __builtin_amdgcn_cvt_pk_fp8_f32(c, d, w, true); return (unsigned)w; }
__device__ __forceinline__ void xb_rows(const Frame& F, const float* X, bf16_t* XB, float* RS, unsigned char* XB8, float* RSQ) {
    for (int m = F.bid * 8 + F.wave; m < SEQ; m += F.G * 8) {
        const f32x4* xr = (const f32x4*)(X + (size_t)m * DM) + F.lane;
        f32x4 v[16]; float ss = 0.f, am = 0.f;
#pragma unroll
        for (int j = 0; j < 16; ++j) { v[j] = xr[64 * j]; ss += (v[j][0] * v[j][0] + v[j][1] * v[j][1]) + (v[j][2] * v[j][2] + v[j][3] * v[j][3]); }
        const float rstd = rsqrtf(wave_sum(F.lane, ss) * (1.0f / DM) + EPS);
        u32x2* o = (u32x2*)(XB + (size_t)m * DM) + F.lane;
#pragma unroll
        for (int j = 0; j < 16; ++j) { u32x2 w; w.x = cvt_pk_bf16(v[j][0], v[j][1]); w.y = cvt_pk_bf16(v[j][2], v[j][3]); o[64 * j] = w;
            v[j] = (f32x4){bflo(w.x), bfhi(w.x), bflo(w.y), bfhi(w.y)};
            am = fmaxf(fmaxf(am, fmaxf(fabsf(v[j][0]), fabsf(v[j][1]))), fmaxf(fabsf(v[j][2]), fabsf(v[j][3]))); }
        am = wave_max(F.lane, am);
        const float inv = am > 0.f ? 127.0f / am : 0.f;
#pragma unroll
        for (int j = 0; j < 16; ++j) ((unsigned*)(XB8 + (size_t)m * DM))[64 * j + F.lane] = pack_i8x4(v[j][0] * inv, v[j][1] * inv, v[j][2] * inv, v[j][3] * inv);
        if (F.lane == 0) { RS[m] = rstd; RSQ[m] = rstd * am * (1.0f / (127.0f * 127.0f)); }
    }
}
__device__ __forceinline__ void rn_issue(u32x2 (&xb)[16], const bf16_t* Y, const bf16_t* XB, int m, int lane, LAS unsigned char* ybuf) {
    const char* yr = (const char*)(Y + (size_t)m * DM) + lane * 16;
#pragma unroll
    for (int j = 0; j < 8; ++j) __builtin_amdgcn_global_load_lds((const unsigned*)(yr + j * 1024), (LAS unsigned*)(ybuf + j * 1024), 16, 0, 0);
    const u32x2* xr = (const u32x2*)(XB + (size_t)m * DM) + lane;
#pragma unroll
    for (int j = 0; j < 16; ++j) xb[j] = xr[64 * j];
}
__device__ __forceinline__ void rn_process(const u32x2 (&xb)[16], u32x2 (&y)[16], const LAS float* gpost, bf16_t* XB, float* RS, float* OUT32, unsigned char* XB8, float* RSQ, int m, int lane) {
    float ss = 0.f;
#pragma unroll
    for (int j = 0; j < 16; ++j) { const float a = bflo(y[j].x), c = bfhi(y[j].x), d = bflo(y[j].y), e = bfhi(y[j].y); ss += (a * a + c * c) + (d * d + e * e); }
    const float rstd = rsqrtf(wave_sum(lane, ss) * (1.0f / DM) + EPS);
    float s2 = 0.f, am = 0.f;
#pragma unroll
    for (int j = 0; j < 16; ++j) { const f32x4 g = ((const LAS f32x4*)gpost)[64 * j + lane]; const f32x4 yv = (f32x4){bflo(y[j].x), bfhi(y[j].x), bflo(y[j].y), bfhi(y[j].y)};
        const f32x4 xo = (f32x4){bflo(xb[j].x), bfhi(xb[j].x), bflo(xb[j].y), bfhi(xb[j].y)};
        const f32x4 xn = xo + yv * rstd * g; s2 += (xn[0] * xn[0] + xn[1] * xn[1]) + (xn[2] * xn[2] + xn[3] * xn[3]);
        if (OUT32) ((f32x4*)(OUT32 + (size_t)m * DM))[64 * j + lane] = xn;
        else { u32x2 w; w.x = cvt_pk_bf16(xn[0], xn[1]); w.y = cvt_pk_bf16(xn[2], xn[3]); ((u32x2*)(XB + (size_t)m * DM))[64 * j + lane] = w;
            if (XB8) { y[j] = w;
                am = fmaxf(fmaxf(am, fmaxf(fabsf(bflo(w.x)), fabsf(bfhi(w.x)))), fmaxf(fabsf(bflo(w.y)), fabsf(bfhi(w.y)))); } } }
    if (!OUT32) { const float rstd2 = rsqrtf(wave_sum(lane, s2) * (1.0f / DM) + EPS); if (lane == 0) RS[m] = rstd2;
        if (XB8) { am = wave_max(lane, am); const float inv = am > 0.f ? 127.0f / am : 0.f;
#pragma unroll
            for (int j = 0; j < 16; ++j) ((unsigned*)(XB8 + (size_t)m * DM))[64 * j + lane] = pack_i8x4(bflo(y[j].x) * inv, bfhi(y[j].x) * inv, bflo(y[j].y) * inv, bfhi(y[j].y) * inv);
            if (lane == 0) RSQ[m] = rstd2 * am * (1.0f / (127.0f * 127.0f)); } }
}
__device__ __forceinline__ void resnorm_rows(const Frame& F, const bf16_t* Y, const float* gpost, const bf16_t* XBin, bf16_t* XB, float* RS, float* OUT32, unsigned char* XB8, float* RSQ) {
    const int step = F.G * 8; int m = F.bid * 8 + F.wave;
    LAS unsigned char* ybuf = F.lds + F.wave * 8192;
    LAS float* gl = (LAS float*)(F.lds + 65536);
    __syncthreads();
    for (int i = F.tid; i < DM / 4; i += 512) ((LAS f32x4*)gl)[i] = ((const f32x4*)gpost)[i];
    __syncthreads();
    u32x2 xa[16], xb2[16], y[16];
    if (m < SEQ) rn_issue(xa, Y, XBin, m, F.lane, ybuf);
#define RN_TAKE_Y() do { asm volatile("s_waitcnt vmcnt(0)" ::: "memory"); _Pragma("unroll") for (int j = 0; j < 16; ++j) y[j] = *(const LAS u32x2*)(ybuf + j * 512 + F.lane * 8); \
        asm volatile("s_waitcnt lgkmcnt(0)" ::: "memory"); } while (0)
    while (m < SEQ) {
        const int m1 = m + step, m2 = m + 2 * step;
        RN_TAKE_Y();
        if (m1 < SEQ) rn_issue(xb2, Y, XBin, m1, F.lane, ybuf);
        rn_process(xa, y, gl, XB, RS, OUT32, XB8, RSQ, m, F.lane);
        if (m1 >= SEQ) break;
        RN_TAKE_Y();
        if (m2 < SEQ) rn_issue(xa, Y, XBin, m2, F.lane, ybuf);
        rn_process(xb2, y, gl, XB, RS, OUT32, XB8, RSQ, m1, F.lane);
        m = m2;
    }
#undef RN_TAKE_Y
    asm volatile("s_waitcnt vmcnt(0)" ::: "memory");
    __syncthreads();
}
__device__ __forceinline__ void prep_rows(const Frame& F, bf16_t* Z, const float* gq, const float* gkv, const float* ropec, const float* ropes) {
    for (int m = F.bid * 8 + F.wave; m < SEQ; m += F.G * 8) {
        bf16_t* zr = Z + (size_t)m * N_INP;
        {   u32x2* p = (u32x2*)(zr + ZC_CQ) + F.lane; f32x4 v[3]; float ss = 0.f;
#pragma unroll
            for (int j = 0; j < 3; ++j) { const u32x2 w = p[64 * j]; v[j] = (f32x4){bflo(w.x), bfhi(w.x), bflo(w.y), bfhi(w.y)}; ss += (v[j][0] * v[j][0] + v[j][1] * v[j][1]) + (v[j][2] * v[j][2] + v[j][3] * v[j][3]); }
            const float rstd = rsqrtf(wave_sum(F.lane, ss) * (1.0f / Q_LORA) + EPS);
#pragma unroll
            for (int j = 0; j < 3; ++j) { const f32x4 g = ((const f32x4*)gq)[64 * j + F.lane]; const f32x4 y = v[j] * rstd * g; u32x2 w; w.x = cvt_pk_bf16(y[0], y[1]); w.y = cvt_pk_bf16(y[2], y[3]); p[64 * j] = w; } }
        {   u32x2* p = (u32x2*)(zr + ZC_CKV) + F.lane; f32x4 v[2]; float ss = 0.f;
#pragma unroll
            for (int j = 0; j < 2; ++j) { const u32x2 w = p[64 * j]; v[j] = (f32x4){bflo(w.x), bfhi(w.x), bflo(w.y), bfhi(w.y)}; ss += (v[j][0] * v[j][0] + v[j][1] * v[j][1]) + (v[j][2] * v[j][2] + v[j][3] * v[j][3]); }
            const float rstd = rsqrtf(wave_sum(F.lane, ss) * (1.0f / KV_LORA) + EPS);
#pragma unroll
            for (int j = 0; j < 2; ++j) { const f32x4 g = ((const f32x4*)gkv)[64 * j + F.lane]; const f32x4 y = v[j] * rstd * g; u32x2 w; w.x = cvt_pk_bf16(y[0], y[1]); w.y = cvt_pk_bf16(y[2], y[3]); p[64 * j] = w; } }
        if (F.lane < 32) { bf16_t* kr = zr + ZC_KR; const float t1 = bf2f(kr[F.lane]), t2 = bf2f(kr[32 + F.lane]); const float c = ropec[(size_t)m * 32 + F.lane], s = ropes[(size_t)m * 32 + F.lane];
            kr[F.lane] = f2bf(t1 * c - t2 * s); kr[32 + F.lane] = f2bf(t2 * c + t1 * s); }
    }
}
__device__ __forceinline__ void transpose_item(const float* W, int pitch, int K, bf16_t* WT, const float* gain, const float* cs, int mode, LAS float* scr, int kb, int nb, int lane) {
    const int k0 = 64 * kb, n0 = 32 * nb;
    const int d0 = (mode & 1) ? ((n0 % D_FF) / 128) * 256 + (n0 >= D_FF ? 128 : 0) + (n0 % 128) : n0;
#pragma unroll 8
    for (int i = 0; i < 32; ++i) { const int kk = 2 * i + (lane >> 5); scr[kk * 33 + (lane & 31)] = W[(size_t)(k0 + kk) * pitch + n0 + (lane & 31)]; }
    LDS_WAIT(); asm volatile("" ::: "memory");
    const int c = lane & 7;
    f32x4 ga = (f32x4){1.f, 1.f, 1.f, 1.f}, gb = ga; if (gain) { ga = *(const f32x4*)(gain + k0 + 8 * c); gb = *(const f32x4*)(gain + k0 + 8 * c + 4); }
#pragma unroll
    for (int j = 0; j < 4; ++j) { const int n = (lane >> 3) + 8 * j; const LAS float* s = scr + (8 * c) * 33 + n;
        u32x4 o; o.x = cvt_pk_bf16(s[0 * 33] * ga[0], s[1 * 33] * ga[1]); o.y = cvt_pk_bf16(s[2 * 33] * ga[2], s[3 * 33] * ga[3]); o.z = cvt_pk_bf16(s[4 * 33] * gb[0], s[5 * 33] * gb[1]); o.w = cvt_pk_bf16(s[6 * 33] * gb[2], s[7 * 33] * gb[3]);
        if (mode & 4) {
            const float am = cs[d0 + n], inv = am > 0.f ? 127.0f / am : 0.f;
            const unsigned w0 = pack_i8x4(s[0 * 33] * ga[0] * inv, s[1 * 33] * ga[1] * inv, s[2 * 33] * ga[2] * inv, s[3 * 33] * ga[3] * inv);
            const unsigned w1 = pack_i8x4(s[4 * 33] * gb[0] * inv, s[5 * 33] * gb[1] * inv, s[6 * 33] * gb[2] * inv, s[7 * 33] * gb[3] * inv);
            *(u32x2*)((unsigned char*)WT + (size_t)(d0 + n) * K + k0 + 8 * c) = (u32x2){w0, w1}; }
        else if (mode == 2) {
            int w0 = 0, w1 = 0;
            w0 = __builtin_amdgcn_cvt_pk_fp8_f32(s[0 * 33] * ga[0] * WG8_SCALE, s[1 * 33] * ga[1] * WG8_SCALE, w0, false); w0 = __builtin_amdgcn_cvt_pk_fp8_f32(s[2 * 33] * ga[2] * WG8_SCALE, s[3 * 33] * ga[3] * WG8_SCALE, w0, true);
            w1 = __builtin_amdgcn_cvt_pk_fp8_f32(s[4 * 33] * gb[0] * WG8_SCALE, s[5 * 33] * gb[1] * WG8_SCALE, w1, false); w1 = __builtin_amdgcn_cvt_pk_fp8_f32(s[6 * 33] * gb[2] * WG8_SCALE, s[7 * 33] * gb[3] * WG8_SCALE, w1, true);
            *(u32x2*)((unsigned char*)WT + (size_t)(d0 + n) * K + k0 + 8 * c) = (u32x2){(unsigned)w0, (unsigned)w1}; }
        else *(u32x4*)(WT + (size_t)(d0 + n) * K + k0 + 8 * c) = o; }
    LDS_WAIT(); asm volatile("" ::: "memory");
}
__device__ __forceinline__ bool q_locate(const __attribute__((address_space(4))) Args* ap, int T, int& jo, int& so) {
    for (int j = 0; j < NJOBS; ++j) { if (!(ap->jobs[j].mode & 4)) continue; const int n = ap->jobs[j].ncols / 16; if (T < n) { jo = j; so = T; return true; } T -= n; }
    return false;
}
__device__ __forceinline__ void quant_jobs(const Frame& F, const __attribute__((address_space(4))) Args* ap) {
    constexpr int CP = 8208;
    LAS unsigned char* stg = F.lds; LAS float* red = (LAS float*)(F.lds + 16 * CP);
    const int c = F.lane & 15, kp = F.lane >> 4, kw0 = F.wave * 512 + 2 * kp;
    int T, step;
    if ((F.G & 15) == 0) { const int x = F.bid & 7, r = F.bid >> 3; T = 2 * (x + 8 * (r >> 1)) + (r & 1); step = F.G; }
    else { T = F.bid; step = F.G; }
    float R[128];
#define Q_ISSUE(J, ST) do { const float* p_ = ap->jobs[J].src + ap->jobs[J].n0 + (size_t)kw0 * ap->jobs[J].pitch + 16 * (ST) + c; const size_t pitch_ = (size_t)ap->jobs[J].pitch; \
        _Pragma("unroll") for (int i = 0; i < 64; ++i) { R[2 * i] = p_[(size_t)(8 * i) * pitch_]; R[2 * i + 1] = p_[(size_t)(8 * i + 1) * pitch_]; } } while (0)
    int j = 0, st = 0; bool have = q_locate(ap, T, j, st);
    if (have) Q_ISSUE(j, st);
    while (have) {
        const float* gain = ap->jobs[j].gain; float* cs = ap->jobs[j].cs; unsigned char* dst = (unsigned char*)ap->jobs[j].dst; const int mode = ap->jobs[j].mode;
        const float* gp = gain + kw0;
        LAS unsigned char* sp = stg + c * CP + kw0 * 2;
        float mx = 0.f;
#pragma unroll
        for (int i = 0; i < 64; ++i) { const float g0 = gain ? gp[8 * i] : 1.0f, g1 = gain ? gp[8 * i + 1] : 1.0f;
            const unsigned pk = cvt_pk_bf16(R[2 * i] * g0, R[2 * i + 1] * g1); mx = fmaxf(mx, fmaxf(fabsf(bflo(pk)), fabsf(bfhi(pk))));
            *(LAS unsigned*)(sp + 16 * i) = pk; }
        mx = fmaxf(mx, xshfl(F.lane, mx, 16)); mx = fmaxf(mx, xshfl(F.lane, mx, 32));
        if (F.lane < 16) red[F.wave * 16 + c] = mx;
        __syncthreads();
        int jn = 0, sn = 0; const bool hn = q_locate(ap, T + step, jn, sn);
        if (hn) Q_ISSUE(jn, sn);
#pragma unroll
        for (int cc = 0; cc < 2; ++cc) { const int col = 2 * F.wave + cc; float am = red[col];
#pragma unroll
            for (int w = 1; w < 8; ++w) am = fmaxf(am, red[w * 16 + col]);
            const float inv = am > 0.f ? 127.0f / am : 0.f;
            const int n = 16 * st + col; const int d = (mode & 1) ? ((n % D_FF) / 128) * 256 + (n >= D_FF ? 128 : 0) + (n % 128) : n;
            unsigned char* orow = dst + (size_t)d * DM;
#pragma unroll
            for (int q = 0; q < 8; ++q) { const u32x4 a = *(const LAS u32x4*)(stg + col * CP + (q * 64 + F.lane) * 16);
                u32x2 o; o.x = pack_i8x4(bflo(a.x) * inv, bfhi(a.x) * inv, bflo(a.y) * inv, bfhi(a.y) * inv); o.y = pack_i8x4(bflo(a.z) * inv, bfhi(a.z) * inv, bflo(a.w) * inv, bfhi(a.w) * inv);
                *(u32x2*)(orow + (q * 64 + F.lane) * 8) = o; }
            if (F.lane == 0) cs[d] = am; }
        __syncthreads();
        T += step; j = jn; st = sn; have = hn;
    }
#undef Q_ISSUE
}
__device__ __forceinline__ void prologue_phase(const Frame& F, const __attribute__((address_space(4))) Args* ap) {
    unsigned char* ws = ap->ws;
    LAS float* scr = (LAS float*)(F.lds + F.wave * 16384);
    const int gw = F.bid * 8 + F.wave, NGW = F.G * 8;
    quant_jobs(F, ap);
    for (int j = 0; j < NJOBS; ++j) { if (ap->jobs[j].mode & 4) continue;
        TrJob jb; jb.src = ap->jobs[j].src; jb.dst = ap->jobs[j].dst; jb.gain = ap->jobs[j].gain; jb.cs = ap->jobs[j].cs; jb.mode = ap->jobs[j].mode; jb.K = ap->jobs[j].K; jb.pitch = ap->jobs[j].pitch; jb.n0 = ap->jobs[j].n0; jb.ncols = ap->jobs[j].ncols; const int nblk = jb.ncols / 32, nit = (jb.K / 64) * nblk;
        const float* src = jb.src + jb.n0;
        for (int it = gw; it < nit; it += NGW) transpose_item(src, jb.pitch, jb.K, jb.dst, jb.gain, jb.cs, jb.mode, scr, it / nblk, it % nblk, F.lane);
    }
    const int gt = F.bid * 512 + F.tid, NGT = F.G * 512;
    for (int l = 0; l < DEPTH; ++l) { u32x4* p = (u32x4*)(ws + WS_W + (size_t)l * W_LAYER + WO_ING + (size_t)(N_ZB - (N_INP - N_IN)) * DM * 2);
        for (int i = gt; i < (N_INP - N_IN) * DM * 2 / 16; i += NGT) p[i] = (u32x4){0u, 0u, 0u, 0u}; }
    bf16_t* dre = (bf16_t*)(ws + WS_DRE); bf16_t* dim = (bf16_t*)(ws + WS_DIM); bf16_t* f1 = (bf16_t*)(ws + WS_F1); bf16_t* f3 = (bf16_t*)(ws + WS_F3);
    for (int i = gt; i < 65536; i += NGT) { const int r = i >> 8, c = i & 255;
        { const float x = 2.0f * (float)((r * c) & 255) * (1.0f / 256.0f); dre[i] = f2bf(cospif(x) * 0.0625f); dim[i] = f2bf(-sinpif(x) * 0.0625f); }
        { const int k2 = r & 127, rip = r >> 7, aa = c & 127, ri = c >> 7; const float x = 2.0f * (float)((k2 * aa) & 127) * (1.0f / 128.0f); const float cs = cospif(x) * 0.08838834764831845f, sn = sinpif(x) * 0.08838834764831845f;
          f1[i] = f2bf(rip == ri ? cs : (rip == 0 ? sn : -sn));
          f3[i] = f2bf(r < 128 ? (ri == 0 ? cs : sn) : 0.f); } }
    float* twc = (float*)(ws + WS_TWC); float* tws = (float*)(ws + WS_TWS);
    for (int i = gt; i < 16384; i += NGT) { const int k2 = i >> 7, b = i & 127; const float x = 2.0f * (float)(k2 * b) * (1.0f / 16384.0f); twc[i] = cospif(x); tws[i] = sinpif(x); }
    float* rc = (float*)(ws + WS_ROPEC); float* rs = (float*)(ws + WS_ROPES); const int* pos = (const int*)ap->in[2];
    for (int i = gt; i < SEQ * 32; i += NGT) { const int m = i >> 5, k = i & 31; const float inv = powf(10000.0f, -(float)(2 * k) / 64.0f); const float ang = (float)pos[m] * inv; rc[i] = cosf(ang); rs[i] = sinf(ang); }
    { const float* wsp = ap->in[11]; bf16_t* sgw = (bf16_t*)(ws + WS_SGW);
      for (int i = gt; i < DEPTH * 16 * 128 * 128 / 2; i += NGT) { const f32x2 v = ((const f32x2*)wsp)[i]; ((unsigned*)sgw)[i] = cvt_pk_bf16(v[0], v[1]); } }
    for (int l = 0; l < DEPTH; ++l) norm_rows(F, ap->in[1], ap->in[21] + (size_t)l * DM, (bf16_t*)(ws + WS_MEMN) + (size_t)l * MEM_T * DM, MEM_T);
    xb_rows(F, ap->in[0], (bf16_t*)(ws + WS_H), (float*)(ws + WS_RSTD), ws + WS_XB8, (float*)(ws + WS_RSQ));
}

__device__ __forceinline__ void sg_phase(const Frame& F, const bf16_t* Z, const bf16_t* sgw, const float* lng, const float* bsp, bf16_t* SGO) {
    constexpr int VTP = 272;
    LAS unsigned char* vt = F.lds;
    const int t = F.tid, q = t >> 2, sub = t & 3, lane = F.lane, r32 = lane & 31, hi = lane >> 5, pblk = F.wave >> 1, dh = F.wave & 1;
    for (int u = F.bid; u < 128 * 16; u += F.G) {
        const int ck = u >> 4, g = u & 15;
        __syncthreads();
        {   const bf16_t* vrow = Z + (size_t)(ck * 128 + q) * N_INP + ZC_SGV + g * 128;
            float x[4][8]; float s = 0.f;
#pragma unroll
            for (int i = 0; i < 4; ++i) { const u32x4 w = *(const u32x4*)(vrow + (sub + 4 * i) * 8);
#pragma unroll
                for (int j = 0; j < 4; ++j) { x[i][2 * j] = bflo(w[j]); x[i][2 * j + 1] = bfhi(w[j]); s += x[i][2 * j] + x[i][2 * j + 1]; } }
            s += xshfl(lane, s, 1); s += xshfl(lane, s, 2);
            const float mu = s * (1.0f / 128.0f); float qq = 0.f;
#pragma unroll
            for (int i = 0; i < 4; ++i)
#pragma unroll
                for (int j = 0; j < 8; ++j) { x[i][j] -= mu; qq += x[i][j] * x[i][j]; }
            qq += xshfl(lane, qq, 1); qq += xshfl(lane, qq, 2);
            const float rstd = rsqrtf(qq * (1.0f / 128.0f) + EPS);
#pragma unroll
            for (int i = 0; i < 4; ++i) { const int d0 = (sub + 4 * i) * 8;
                const f32x4 g0 = *(const f32x4*)(lng + g * 128 + d0), g1 = *(const f32x4*)(lng + g * 128 + d0 + 4);
#pragma unroll
                for (int j = 0; j < 8; ++j) { const float y = x[i][j] * rstd * (j < 4 ? g0[j & 3] : g1[j & 3]);
                    *(LAS bf16_t*)(vt + (d0 + j) * VTP + q * 2) = f2bf(y); } }
        }
        __syncthreads();
        f32x16 acc0 = {}, acc1 = {};
        const bf16_t* wrow = sgw + ((size_t)g * 128 + pblk * 32 + r32) * 128 + hi * 8;
        const LAS unsigned char* a0p = vt + ((dh * 2 + 0) * 32 + r32) * VTP + hi * 16;
        const LAS unsigned char* a1p = vt + ((dh * 2 + 1) * 32 + r32) * VTP + hi * 16;
#pragma unroll
        for (int ks = 0; ks < 8; ++ks) {
            const bf16x8 bw = *(const bf16x8*)(wrow + ks * 16);
            const bf16x8 a0 = *(const LAS bf16x8*)(a0p + ks * 32), a1 = *(const LAS bf16x8*)(a1p + ks * 32);
            acc0 = __builtin_amdgcn_mfma_f32_32x32x16_bf16(a0, bw, acc0, 0, 0, 0);
            acc1 = __builtin_amdgcn_mfma_f32_32x32x16_bf16(a1, bw, acc1, 0, 0, 0);
        }
        const int p = pblk * 32 + r32; const float bp = bsp[g * 128 + p];
        const bf16_t* urow = Z + (size_t)(ck * 128 + p) * N_INP + ZC_SGU + g * 128;
        bf16_t* orow = SGO + (size_t)(ck * 128 + p) * SG_WIDTH + g * 128;
#pragma unroll
        for (int db = 0; db < 2; ++db)
#pragma unroll
            for (int rg = 0; rg < 4; ++rg) { const int d0 = (dh * 2 + db) * 32 + 8 * rg + 4 * hi;
                const u32x2 uw = *(const u32x2*)(urow + d0);
                const float s0 = (db ? acc1[4 * rg + 0] : acc0[4 * rg + 0]) + bp, s1 = (db ? acc1[4 * rg + 1] : acc0[4 * rg + 1]) + bp, s2 = (db ? acc1[4 * rg + 2] : acc0[4 * rg + 2]) + bp, s3 = (db ? acc1[4 * rg + 3] : acc0[4 * rg + 3]) + bp;
                u32x2 w; w.x = cvt_pk_bf16(bflo(uw.x) * s0, bfhi(uw.x) * s1); w.y = cvt_pk_bf16(bflo(uw.y) * s2, bfhi(uw.y) * s3);
                *(u32x2*)(orow + d0) = w; }
    }
    __syncthreads();
}
#ifndef ATT_ILV
#define ATT_ILV 0
#endif
namespace att {
constexpr int NW = 8, QBLK = 32, KVBLK = 64;
constexpr float SCALE = 0.07216878364870322f;
#ifndef ATT_THR
#define ATT_THR 8.f
#endif
constexpr float THR = ATT_THR;
constexpr int SHM_V = 16384, SHM_KN = 16384, SHM_KR = 8192;
constexpr int OFF_V = 0, OFF_KN = 2 * SHM_V, OFF_KR = OFF_KN + 2 * SHM_KN, OFF_WS = OFF_KR + 2 * SHM_KR, ATT_LDS = OFF_WS + NW * 64 * 4;
#define KNSWZ(row, colB) ((row) * 256 + ((colB) ^ (((row) & 15) << 4)))
#define KRSWZ(row, colB) ((row) * 128 + ((colB) ^ ((((row) >> 1) & 7) << 4)))
#define SBAR() __builtin_amdgcn_sched_barrier(0)
#if ATT_ILV
#define QK_ILV() do { _Pragma("unroll") for (int i_ = 0; i_ < 24; ++i_) { __builtin_amdgcn_sched_group_barrier(0x008, 1, 0); __builtin_amdgcn_sched_group_barrier(0x100, 2, 0); __builtin_amdgcn_sched_group_barrier(0x002, ATT_ILV, 0); } } while (0)
#else
#define QK_ILV() do { } while (0)
#endif
__device__ __forceinline__ int crow(int r, int hi) { return (r & 3) + 8 * (r >> 2) + 4 * hi; }
__device__ __forceinline__ void partialSM(f32x16& p0, f32x16& p1, float& m_reg, float& mn, float& alpha) {
    constexpr float C = SCALE * 1.4426950408889634f;
    float pmax = p0[0];
#pragma unroll
    for (int r = 1; r < 16; ++r) pmax = fmaxf(pmax, p0[r]);
#pragma unroll
    for (int r = 0; r < 16; ++r) pmax = fmaxf(pmax, p1[r]);
    { auto rr = __builtin_amdgcn_permlane32_swap(__float_as_uint(pmax), __float_as_uint(pmax), false, false);
      pmax = fmaxf(__uint_as_float(rr[0]), __uint_as_float(rr[1])); }
    if (__builtin_expect(__all(pmax - m_reg <= THR / SCALE), 1)) { mn = m_reg; alpha = 1.f; }
    else { mn = fmaxf(m_reg, pmax); alpha = __builtin_amdgcn_exp2f((m_reg - mn) * C); m_reg = mn; }
    const float mnC = -mn * C;
#pragma unroll
    for (int r = 0; r < 16; ++r) p0[r] = fmaf(p0[r], C, mnC);
#pragma unroll
    for (int r = 0; r < 16; ++r) p1[r] = fmaf(p1[r], C, mnC);
#pragma unroll
    for (int r = 0; r < 16; ++r) p0[r] = __builtin_amdgcn_exp2f(p0[r]);
}
__device__ __forceinline__ void finishSM(f32x16& p0, f32x16& p1, float alpha, float& l_reg, bf16x8& pa0, bf16x8& pa1, bf16x8& pa2, bf16x8& pa3) {
#pragma unroll
    for (int r = 0; r < 16; ++r) p1[r] = __builtin_amdgcn_exp2f(p1[r]);
    float ps = 0;
#pragma unroll
    for (int r = 0; r < 16; ++r) ps += p0[r];
#pragma unroll
    for (int r = 0; r < 16; ++r) ps += p1[r];
    { auto rr = __builtin_amdgcn_permlane32_swap(__float_as_uint(ps), __float_as_uint(ps), false, false);
      ps = __uint_as_float(rr[0]) + __uint_as_float(rr[1]); }
    l_reg = l_reg * alpha + ps;
#define PK4(P, BASE, OUT) do { unsigned a0 = cvt_pk_bf16(P[BASE + 0], P[BASE + 1]), a1 = cvt_pk_bf16(P[BASE + 2], P[BASE + 3]);   \
    unsigned b0 = cvt_pk_bf16(P[BASE + 4], P[BASE + 5]), b1 = cvt_pk_bf16(P[BASE + 6], P[BASE + 7]);                              \
    auto r0 = __builtin_amdgcn_permlane32_swap(a0, b0, false, false); auto r1 = __builtin_amdgcn_permlane32_swap(a1, b1, false, false); \
    u32x4 w = {r0[0], r1[0], r0[1], r1[1]}; OUT = *reinterpret_cast<bf16x8*>(&w); } while (0)
    PK4(p0, 0, pa0); PK4(p0, 8, pa1); PK4(p1, 0, pa2); PK4(p1, 8, pa3);
#undef PK4
}
__device__ __forceinline__ void qkt(f32x16& p0, f32x16& p1, const LAS unsigned char* Kn, const LAS unsigned char* Kr, const bf16x8 (&qr)[12], int r32, int hi) {
    p0 = f32x16{}; p1 = f32x16{};
#pragma unroll
    for (int d0 = 0; d0 < 8; ++d0) { const int cb = (d0 * 16 + hi * 8) * 2;
        const bf16x8 b0 = *(const LAS bf16x8*)(Kn + KNSWZ(r32, cb));
        const bf16x8 b1 = *(const LAS bf16x8*)(Kn + KNSWZ(32 + r32, cb));
        p0 = __builtin_amdgcn_mfma_f32_32x32x16_bf16(b0, qr[d0], p0, 0, 0, 0);
        p1 = __builtin_amdgcn_mfma_f32_32x32x16_bf16(b1, qr[d0], p1, 0, 0, 0); }
#pragma unroll
    for (int d0 = 0; d0 < 4; ++d0) { const int cb = (d0 * 16 + hi * 8) * 2;
        const bf16x8 b0 = *(const LAS bf16x8*)(Kr + KRSWZ(r32, cb));
        const bf16x8 b1 = *(const LAS bf16x8*)(Kr + KRSWZ(32 + r32, cb));
        p0 = __builtin_amdgcn_mfma_f32_32x32x16_bf16(b0, qr[8 + d0], p0, 0, 0, 0);
        p1 = __builtin_amdgcn_mfma_f32_32x32x16_bf16(b1, qr[8 + d0], p1, 0, 0, 0); }
}
__device__ __forceinline__ int v_st(int k, int c) { const int kk = (k & ~0xC) | ((k & 4) << 1) | ((k & 8) >> 1); return ((kk >> 3) * 4 + (c >> 5)) * 512 + ((kk & 7) * 32 + (c & 31)) * 2; }
__device__ __forceinline__ int v_rd_base(int lane) { return ((lane & 3) << 3) | (((lane >> 2) & 3) << 6) | (((lane >> 4) & 1) << 5) | (((lane >> 5) & 1) << 8); }
constexpr int v_rd_off(int d0, int ks, int half) { return d0 * 512 + ks * 4096 + half * 2048; }
template <int OFF> __device__ __forceinline__ s16x4 tr_read(int vb) {
    s16x4 r; asm volatile("ds_read_b64_tr_b16 %0, %1 offset:%2" : "=&v"(r) : "v"(vb), "i"(OFF) : "memory"); return r;
}
template <int D0> __device__ __forceinline__ void pv_one(f32x16& od, int vb, bf16x8 pa0, bf16x8 pa1, bf16x8 pa2, bf16x8 pa3) {
    const s16x4 l0 = tr_read<v_rd_off(D0, 0, 0)>(vb), h0 = tr_read<v_rd_off(D0, 0, 1)>(vb), l1 = tr_read<v_rd_off(D0, 1, 0)>(vb), h1 = tr_read<v_rd_off(D0, 1, 1)>(vb);
    const s16x4 l2 = tr_read<v_rd_off(D0, 2, 0)>(vb), h2 = tr_read<v_rd_off(D0, 2, 1)>(vb), l3 = tr_read<v_rd_off(D0, 3, 0)>(vb), h3 = tr_read<v_rd_off(D0, 3, 1)>(vb);
    asm volatile("s_waitcnt lgkmcnt(0)" ::: "memory"); SBAR();
#define PK(L, H) (bf16x8){L[0], L[1], L[2], L[3], H[0], H[1], H[2], H[3]}
    od = __builtin_amdgcn_mfma_f32_32x32x16_bf16(pa0, PK(l0, h0), od, 0, 0, 0);
    od = __builtin_amdgcn_mfma_f32_32x32x16_bf16(pa1, PK(l1, h1), od, 0, 0, 0);
    od = __builtin_amdgcn_mfma_f32_32x32x16_bf16(pa2, PK(l2, h2), od, 0, 0, 0);
    od = __builtin_amdgcn_mfma_f32_32x32x16_bf16(pa3, PK(l3, h3), od, 0, 0, 0);
#undef PK
}
__device__ __forceinline__ void pv_d0(f32x16 (&o)[4], int vb, bf16x8 pa0, bf16x8 pa1, bf16x8 pa2, bf16x8 pa3) {
    pv_one<0>(o[0], vb, pa0, pa1, pa2, pa3); pv_one<1>(o[1], vb, pa0, pa1, pa2, pa3); pv_one<2>(o[2], vb, pa0, pa1, pa2, pa3); pv_one<3>(o[3], vb, pa0, pa1, pa2, pa3);
}
constexpr int BUF = SHM_V + SHM_KN + SHM_KR;
constexpr int OFF_WS3 = 3 * BUF;
__device__ __forceinline__ void attn_unit(const bf16_t* __restrict__ Q, const bf16_t* __restrict__ KV, const bf16_t* __restrict__ KRp, const float* __restrict__ ropec, const float* __restrict__ ropes,
                                          bf16_t* __restrict__ O, int h, int q0, LAS unsigned char* lds) {
    const int tid = otid(), wid = __builtin_amdgcn_readfirstlane(tid >> 6), lane = tid & 63, r32 = lane & 31, hi = lane >> 5;
    LAS float* wsx = (LAS float*)(lds + OFF_WS3) + wid * 64; LAS float* li_l = wsx; LAS float* al_l = wsx + 32;
    const bf16_t* Kh = KV + h * 256; const bf16_t* Vh = KV + h * 256 + 128;
    unsigned gV[2], gK[2], gR;
#pragma unroll
    for (int i = 0; i < 2; ++i) { const int p = (i * 8 + wid) * 64 + lane;
        { const int st = p >> 5, kk = 8 * (st >> 2) + ((p & 31) >> 2), k = (kk & ~0xC) | ((kk & 4) << 1) | ((kk & 8) >> 1), c = 32 * (st & 3) + 8 * (p & 3); gV[i] = (unsigned)(k * NKV + c); }
        { const int row = p >> 4, lc = (p & 15) ^ (row & 15); gK[i] = (unsigned)(row * NKV + lc * 8); } }
    { const int p = wid * 64 + lane, row = p >> 3, lc = (p & 7) ^ ((row >> 1) & 7); gR = (unsigned)(row * N_INP + lc * 8); }
#define DMA16(src, dstoff) __builtin_amdgcn_global_load_lds((const unsigned*)(src), (LAS unsigned*)(lds + (dstoff)), 16, 0, 0)
#define ISSUE(tile, boff) do { const bf16_t* _v = Vh + (size_t)(tile) * KVBLK * NKV; const bf16_t* _k = Kh + (size_t)(tile) * KVBLK * NKV; const bf16_t* _r = KRp + (size_t)(tile) * KVBLK * N_INP; \
        DMA16(_v + gV[0], (boff) + wid * 1024); DMA16(_v + gV[1], (boff) + 8192 + wid * 1024); \
        DMA16(_k + gK[0], (boff) + SHM_V + wid * 1024); DMA16(_k + gK[1], (boff) + SHM_V + 8192 + wid * 1024); \
        DMA16(_r + gR, (boff) + SHM_V + SHM_KN + wid * 1024); } while (0)
    ISSUE(0, 0); ISSUE(1, BUF);
    float m_reg = -1e30f, l_reg = 0; f32x16 o[4] = {}; bf16x8 qr[12];
    {   const int qrow = q0 + wid * QBLK + r32;
        const bf16_t* Qw = Q + (size_t)qrow * NQ + h * DQK + hi * 8;
#pragma unroll
        for (int d0 = 0; d0 < 12; ++d0) qr[d0] = *(const bf16x8*)(Qw + d0 * 16);
#pragma unroll
        for (int e = 0; e < 2; ++e) { const float* cp = ropec + (size_t)qrow * 32 + e * 16 + hi * 8; const float* sp = ropes + (size_t)qrow * 32 + e * 16 + hi * 8;
            const f32x4 c0 = *(const f32x4*)cp, c1 = *(const f32x4*)(cp + 4), s0 = *(const f32x4*)sp, s1 = *(const f32x4*)(sp + 4);
            bf16x8 a = qr[8 + e], b = qr[10 + e]; unsigned na[4], nb[4];
#pragma unroll
            for (int j = 0; j < 4; ++j) {
                const float t1a = bf2f((unsigned short)a[2 * j]), t1b = bf2f((unsigned short)a[2 * j + 1]), t2a = bf2f((unsigned short)b[2 * j]), t2b = bf2f((unsigned short)b[2 * j + 1]);
                const float ca = (2 * j < 4) ? c0[(2 * j) & 3] : c1[(2 * j) & 3], cb = (2 * j + 1 < 4) ? c0[(2 * j + 1) & 3] : c1[(2 * j + 1) & 3];
                const float sa = (2 * j < 4) ? s0[(2 * j) & 3] : s1[(2 * j) & 3], sb = (2 * j + 1 < 4) ? s0[(2 * j + 1) & 3] : s1[(2 * j + 1) & 3];
                na[j] = cvt_pk_bf16(t1a * ca - t2a * sa, t1b * cb - t2b * sb); nb[j] = cvt_pk_bf16(t2a * ca + t1a * sa, t2b * cb + t1b * sb); }
            u32x4 wa = {na[0], na[1], na[2], na[3]}, wb = {nb[0], nb[1], nb[2], nb[3]};
            qr[8 + e] = *reinterpret_cast<bf16x8*>(&wa); qr[10 + e] = *reinterpret_cast<bf16x8*>(&wb); }
    }
    const int vbase = (int)(unsigned)(uintptr_t)lds + v_rd_base(lane);
#define RESC(a) do { if (__any((a) < 1.f)) { if (hi == 0) al_l[r32] = (a); asm volatile("s_waitcnt lgkmcnt(0)" ::: "memory"); \
    _Pragma("unroll") for (int d = 0; d < 4; ++d) _Pragma("unroll") for (int r = 0; r < 16; ++r) o[d][r] *= al_l[crow(r, hi)]; } } while (0)
#define TILE_SYNC() do { asm volatile("s_waitcnt vmcnt(0) lgkmcnt(0)" ::: "memory"); __builtin_amdgcn_s_barrier(); asm volatile("" ::: "memory"); } while (0)
    f32x16 pA0, pA1, pB0, pB1; float mnA, mnB, alA, alB; bf16x8 pa0, pa1, pa2, pa3; constexpr int NT = SEQ / KVBLK;
    TILE_SYNC();
    qkt(pA0, pA1, lds + SHM_V, lds + SHM_V + SHM_KN, qr, r32, hi); partialSM(pA0, pA1, m_reg, mnA, alA);
    ISSUE(2, 2 * BUF);
    int bc = BUF, bp = 0, bn = 2 * BUF;
    for (int j = 1; j + 1 < NT; j += 2) {
        SBAR(); qkt(pB0, pB1, lds + bc + SHM_V, lds + bc + SHM_V + SHM_KN, qr, r32, hi);
        finishSM(pA0, pA1, alA, l_reg, pa0, pa1, pa2, pa3); QK_ILV(); SBAR();
        pv_d0(o, vbase + bp, pa0, pa1, pa2, pa3); partialSM(pB0, pB1, m_reg, mnB, alB);
        TILE_SYNC();
        ISSUE(j + 2, bp);
        RESC(alB);
        { const int t = bp; bp = bc; bc = bn; bn = t; }
        SBAR(); qkt(pA0, pA1, lds + bc + SHM_V, lds + bc + SHM_V + SHM_KN, qr, r32, hi);
        finishSM(pB0, pB1, alB, l_reg, pa0, pa1, pa2, pa3); QK_ILV(); SBAR();
        pv_d0(o, vbase + bp, pa0, pa1, pa2, pa3); partialSM(pA0, pA1, m_reg, mnA, alA);
        TILE_SYNC();
        if (j + 3 < NT) ISSUE(j + 3, bp);
        RESC(alA);
        { const int t = bp; bp = bc; bc = bn; bn = t; }
    }
    SBAR(); qkt(pB0, pB1, lds + bc + SHM_V, lds + bc + SHM_V + SHM_KN, qr, r32, hi);
    finishSM(pA0, pA1, alA, l_reg, pa0, pa1, pa2, pa3); SBAR();
    pv_d0(o, vbase + bp, pa0, pa1, pa2, pa3); partialSM(pB0, pB1, m_reg, mnB, alB);
    RESC(alB);
    finishSM(pB0, pB1, alB, l_reg, pa0, pa1, pa2, pa3); SBAR();
    pv_d0(o, vbase + bc, pa0, pa1, pa2, pa3);
    if (hi == 0) li_l[r32] = l_reg; asm volatile("s_waitcnt lgkmcnt(0)" ::: "memory");
    float rli[16];
#pragma unroll
    for (int r = 0; r < 16; ++r) rli[r] = __builtin_amdgcn_rcpf(li_l[crow(r, hi)]);
    bf16_t* Ow = O + (size_t)(q0 + wid * QBLK) * MEM_W + h * V_DIM;
#pragma unroll
    for (int r = 0; r < 16; ++r) { const int orow = crow(r, hi);
#pragma unroll
        for (int d0 = 0; d0 < 4; ++d0) Ow[(size_t)orow * MEM_W + d0 * 32 + r32] = f2bf(o[d0][r] * rli[r]); }
#undef DMA16
#undef ISSUE
#undef RESC
#undef TILE_SYNC
}
}
constexpr int PH_PER_LAYER = 18, N_PHASES = 2 + DEPTH * PH_PER_LAYER;
#if MK_CHECK
#include "checks.h"
#else
#define CHECK_PHASE(k) do { } while (0)
#endif

#define CAS __attribute__((address_space(4)))
#define KARGS() ((const CAS Args*)optr((const CAS unsigned char*)__builtin_amdgcn_kernarg_segment_ptr()))
__global__ void __launch_bounds__(512, 2) enc_fwd(Args args) {
    extern __shared__ __attribute__((aligned(16))) unsigned char lds_raw[];
    struct { LAS unsigned char* lds; } F0; F0.lds = (LAS unsigned char*)lds_raw;
#define F F0
    volatile LAS unsigned* MISC = (volatile LAS unsigned*)(F.lds + MISC_OFF);
    unsigned* ctl = (unsigned*)(KARGS()->ws + WS_CTL);
    if (threadIdx.x < 64) MISC[threadIdx.x] = 0u;
    __syncthreads();
    if (KARGS()->ph_hi - KARGS()->ph_lo > 1) (void)xcd_barrier_post(ctl + CW_BAR, MISC + 8);
#define lo (KARGS()->ph_lo)
#define hi (KARGS()->ph_hi)
#ifndef ONLY
#define ONLY -1
#endif
#define RELPH(k) ((k) < 2 ? 100 + (k) : ((k) - 2) % PH_PER_LAYER)
#define IN(k) (lo <= (k) && (k) < hi && (ONLY < 0 || RELPH(k) == ONLY))
#ifndef REPMASK
#define REPMASK 0u
#endif
#define NREP(k) (1 + (int)((REPMASK >> (RELPH(k) >= 100 ? RELPH(k) - 70 : RELPH(k))) & 1u))
#ifndef SPLIT_UP
#define SPLIT_UP 0
#endif
#ifndef GATE_DEAL
#define GATE_DEAL 1
#endif
#ifndef UP_SPLIT
#define UP_SPLIT 1
#endif
#ifndef DOUBLE_BAR
#define DOUBLE_BAR 0
#endif
#define LSEAM(k) do { CHECK_PHASE(k); if (IN((k) + 1)) { VM_WAIT(); __syncthreads(); if (threadIdx.x == 0) { __builtin_amdgcn_fence(__ATOMIC_ACQUIRE, "agent"); VM_WAIT(); } __syncthreads(); } } while (0)
#define SEAM(k) do { CHECK_PHASE(k); if (IN((k) + 1)) { XcdBarrier bar_; bar_.bar = (unsigned*)(KARGS()->ws + WS_CTL) + CW_BAR; bar_.x = xb_xcc_id(); bar_.st = (volatile LAS unsigned*)(ring + MISC_OFF) + 8; xcd_barrier(bar_); if (DOUBLE_BAR) xcd_barrier(bar_); } } while (0)
    LAS unsigned char* const ring = F.lds;
#undef F
    const int G = gridDim.x, bid = blockIdx.x;
#define PTRS() const CAS Args* const ap = KARGS(); unsigned char* const ws = ap->ws; const Frame F = make_frame(ring); (void)F; \
    bf16_t* const H = (bf16_t*)(ws + WS_H); bf16_t* const Z = (bf16_t*)(ws + WS_Z); bf16_t* const GATES = (bf16_t*)(ws + WS_GATES); \
    bf16_t* const WT1 = (bf16_t*)(ws + WS_WT1); bf16_t* const S1O = (bf16_t*)(ws + WS_S1O); bf16_t* const YF = (bf16_t*)(ws + WS_YF); \
    bf16_t* const Qb = (bf16_t*)(ws + WS_Q); bf16_t* const KVb = (bf16_t*)(ws + WS_KV); bf16_t* const OA = (bf16_t*)(ws + WS_OA); bf16_t* const SGO = (bf16_t*)(ws + WS_SGO); \
    bf16_t* const MERGED = (bf16_t*)(ws + WS_MERGED); bf16_t* const Y = (bf16_t*)(ws + WS_Y); \
    bf16_t* const QM = (bf16_t*)(ws + WS_QM); bf16_t* const PM = (bf16_t*)(ws + WS_PM); bf16_t* const OM = (bf16_t*)(ws + WS_OM); \
    bf16_t* const U = (bf16_t*)(ws + WS_U); bf16_t* const ACTB = (bf16_t*)(ws + WS_ACTV); \
    float* const RS = (float*)(ws + WS_RSTD); (void)RS; float* const RSQ = (float*)(ws + WS_RSQ); (void)RSQ; \
    const float* const ropec = (const float*)(ws + WS_ROPEC); const float* const ropes = (const float*)(ws + WS_ROPES); \
    const unsigned char* const wl = ws + WS_W + (size_t)l * W_LAYER; \
    float* const X = ap->out; (void)X; \
    (void)H; (void)Z; (void)GATES; (void)WT1; (void)S1O; (void)YF; (void)Qb; (void)KVb; (void)OA; (void)SGO; (void)MERGED; (void)Y; (void)QM; (void)PM; (void)OM; (void)U; (void)ACTB; (void)ropec; (void)ropes; (void)wl

    if (IN(0)) { _Pragma("unroll 1") for (int rep_ = 0; rep_ < NREP(0); ++rep_) { const Frame F = make_frame(ring); prologue_phase(F, KARGS()); } SEAM(0); }
#pragma unroll 1
    for (int l = 0; l < DEPTH; ++l) {
        const int pb = 2 + PH_PER_LAYER * l;
        if (IN(pb + 0)) { _Pragma("unroll 1") for (int rep_ = 0; rep_ < NREP(pb + 0); ++rep_) { PTRS();
#ifndef TEST_NO_MEMKV
            if (l == 0) {
#pragma unroll 1
                for (int k = 0; k < 4; ++k) { const int lm = k >> 1; const bf16_t* memn = (const bf16_t*)(ws + WS_MEMN) + (size_t)lm * MEM_T * DM; const unsigned char* wm = ws + WS_W + (size_t)lm * W_LAYER;
                    pg8::StaticOrder S; const int c = (bid + 2 * G - G / 2 - 4 * k) % G;
                    pg8::Gemm g = (k & 1) == 0 ? pg8::make_gemm(memn, DM, (const bf16_t*)(wm + WO_MK), DM, MEM_T, MEM_W, DM) : pg8::make_gemm((const bf16_t*)(wm + WO_MV), DM, memn, DM, MEM_W, MEM_T, DM);
                    S.init(g.nM, g.nN, G, c);
                    pg8::EpiStore E{(k & 1) == 0 ? (bf16_t*)(ws + WS_KMEM) + (size_t)lm * MEM_T * MEM_W : (bf16_t*)(ws + WS_VMEMT) + (size_t)lm * MEM_W * MEM_T, (k & 1) == 0 ? MEM_W : MEM_T, (k & 1) == 0 ? (size_t)0 : (size_t)256 * MEM_T, (k & 1) == 0 ? (size_t)256 : (size_t)0, nullptr};
                    pg8::gemm_phase(ring, g, S, E); }
            }
#endif
            {
              pg8::Gemm g = pg8::make_gemm(H, DM, (const bf16_t*)(wl + WO_ING), DM, SEQ, N_ZB, DM); pg8::StaticOrder S; S.init(g.nM, g.nN, G, bid);
              pg8::EpiZB E{Z, RS}; pg8::gemm_phase(ring, g, S, E); }
            {
              pg8::Gemm g; g.A = ws + WS_XB8; g.B = wl + WO_ING + WOI_Q8; g.tsA = (size_t)256 * DM; g.pnA = 0; g.tsB = (size_t)256 * DM; g.pmB = 0; g.rsA = DM; g.rsB = DM;
              g.hsA = (size_t)128 * DM; g.hsB = (size_t)128 * DM; g.nM = SEQ / 256; g.nN = N_Q8 / 256; g.nt = DM / 128; pg8::GateOrder S; S.init(g.nM, g.nN, G, bid);
              S.mode = (G == 256 && GATE_DEAL) ? ((l == 0) ? 2 : 1) : 0; S.r0 = F_INT8 ? 16 : 15;
              pg8::EpiInQ E{Z, GATES, ap->in[17] + (size_t)l * N_GATE, RSQ, (const float*)(ws + WS_CS + (size_t)l * CS_LAYER)}; pg8::gemm_phase<pg8::EpiInQ, 2, pg8::GateOrder>(ring, g, S, E); }
            } SEAM(pb + 0); }
        if (IN(pb + 1)) { _Pragma("unroll 1") for (int rep_ = 0; rep_ < NREP(pb + 1); ++rep_) { PTRS();
            if (rep_ == 0) prep_rows(F, Z, ap->in[6] + (size_t)l * Q_LORA, ap->in[8] + (size_t)l * KV_LORA, ropec, ropes);
#pragma unroll 1
            for (int ri = 0; ri < 2; ++ri) { pg8::Gemm g; g.A = ws + (ri ? WS_DIM : WS_DRE); g.B = Z + ZC_F; g.tsA = 0; g.pnA = 0; g.tsB = (size_t)2 * N_INP * 2; g.pmB = 512; g.rsA = 512u; g.rsB = 128u * N_INP * 2u;
                g.hsA = 65536; g.hsB = (size_t)N_INP * 2; g.nM = 4; g.nN = 64; g.nt = 4; pg8::StaticOrder S; S.init(4, 64, G, bid);
                pg8::EpiCD E{WT1, ri}; pg8::gemm_phase(ring, g, S, E); }
            sg_phase(F, Z, (const bf16_t*)(ws + WS_SGW) + (size_t)l * 16 * 128 * 128, ap->in[10] + (size_t)l * SG_WIDTH, ap->in[12] + (size_t)l * 16 * 128, SGO);
            } SEAM(pb + 1);
        }
        if (IN(pb + 2)) { _Pragma("unroll 1") for (int rep_ = 0; rep_ < NREP(pb + 2); ++rep_) { PTRS();
            { pg8::Gemm g = pg8::make_gemm(Z + ZC_CQ, N_INP, (const bf16_t*)(wl + WO_UQ), Q_LORA, SEQ, NQ, Q_LORA); pg8::StaticOrder S; S.init(g.nM, g.nN, G, bid);
              pg8::EpiStore E{Qb, NQ, (size_t)256 * NQ, 256, nullptr}; pg8::gemm_phase(ring, g, S, E); }
            { pg8::Gemm g = pg8::make_gemm(Z + ZC_CKV, N_INP, (const bf16_t*)(wl + WO_UKV), KV_LORA, SEQ, NKV, KV_LORA); pg8::StaticOrder S; S.init(g.nM, g.nN, G, bid);
              pg8::EpiStore E{KVb, NKV, (size_t)256 * NKV, 256, nullptr}; pg8::gemm_phase(ring, g, S, E); }
            { pg8::Gemm g; g.A = ws + WS_F1; g.B = WT1; g.tsA = 0; g.pnA = 0; g.tsB = 131072; g.pmB = 0; g.rsA = 512u; g.rsB = 512u; g.hsA = 65536; g.hsB = 65536; g.nM = 1; g.nN = 512; g.nt = 4;
              pg8::StaticOrder S; S.init(1, 512, G, bid); pg8::EpiS1 E{S1O, (const float*)(ws + WS_TWC), (const float*)(ws + WS_TWS)}; pg8::gemm_phase(ring, g, S, E); }
            } SEAM(pb + 2);
        }
        if (IN(pb + 3)) { _Pragma("unroll 1") for (int rep_ = 0; rep_ < NREP(pb + 3); ++rep_) { PTRS();
            { pg8::Gemm g; g.A = ws + WS_F3; g.B = S1O; g.tsA = 0; g.pnA = 0; g.tsB = 131072; g.pmB = 0; g.rsA = 512u; g.rsB = 512u; g.hsA = 65536; g.hsB = 65536; g.nM = 1; g.nN = 512; g.nt = 4;
              pg8::StaticOrder S; S.init(1, 512, G, bid); pg8::EpiS3 E{YF}; pg8::gemm_phase(ring, g, S, E); }
            if ((G & 7) == 0 && (SEQ / 256) % (G / 8) == 0) {
                const int per = G / 8; for (int qb = bid >> 3; qb < SEQ / 256; qb += per) { __syncthreads(); att::attn_unit(Qb, KVb, Z + ZC_KR, ropec, ropes, OA, bid & 7, qb * 256, ring); } }
            else for (int u = bid; u < MLA_H * (SEQ / 256); u += G) { __syncthreads(); att::attn_unit(Qb, KVb, Z + ZC_KR, ropec, ropes, OA, u >> 6, (u & 63) * 256, ring); }
            __syncthreads(); } SEAM(pb + 3);
        }
        if (IN(pb + 6)) { _Pragma("unroll 1") for (int rep_ = 0; rep_ < NREP(pb + 6); ++rep_) { PTRS();
#pragma unroll 1
            for (int b = 0; b < 3; ++b) {
                const bf16_t* A = b == 0 ? YF : (b == 1 ? OA : SGO); const int K = b == 2 ? SG_WIDTH : 1024; const bf16_t* W = (const bf16_t*)(wl + (b == 0 ? WO_BRF : (b == 1 ? WO_BRA : WO_BRS)));
                if (b > 0) { VM_WAIT(); __syncthreads(); if (F.tid == 0) { __builtin_amdgcn_fence(__ATOMIC_ACQUIRE, "agent"); VM_WAIT(); } __syncthreads(); }
                pg8::Gemm g = pg8::make_gemm(A, K, W, K, SEQ, DM, K); pg8::StaticOrder S; S.init(g.nM, g.nN, G, bid);
                pg8::EpiMerge E{MERGED, GATES + (size_t)b * DM, b == 0 ? 1 : 0}; pg8::gemm_phase(ring, g, S, E); }
            } SEAM(pb + 6);
        }
        if (IN(pb + 7)) { _Pragma("unroll 1") for (int rep_ = 0; rep_ < NREP(pb + 7); ++rep_) { PTRS(); pg8::Gemm g = pg8::make_gemm(MERGED, DM, (const bf16_t*)(wl + WO_OUT), DM, SEQ, DM, DM); pg8::StaticOrder S; S.init(g.nM, g.nN, G, bid);
            pg8::EpiStore E{Y, DM, (size_t)256 * DM, 256, nullptr}; pg8::gemm_phase(ring, g, S, E); } SEAM(pb + 7); }
        if (IN(pb + 8)) { _Pragma("unroll 1") for (int rep_ = 0; rep_ < NREP(pb + 8); ++rep_) { PTRS(); resnorm_rows(F, Y, ap->in[4] + (size_t)l * DM, H, (rep_ + 1 < NREP(pb + 8)) ? MERGED : H, (rep_ + 1 < NREP(pb + 8)) ? RS + SEQ : RS, nullptr, nullptr, nullptr); } SEAM(pb + 8); }
        if (IN(pb + 9)) { _Pragma("unroll 1") for (int rep_ = 0; rep_ < NREP(pb + 9); ++rep_) { PTRS(); pg8::Gemm g = pg8::make_gemm(H, DM, (const bf16_t*)(wl + WO_MQ), DM, SEQ, MEM_W, DM); pg8::StaticOrder S; S.init(g.nM, g.nN, G, bid);
            pg8::EpiStore E{QM, MEM_W, (size_t)256 * MEM_W, 256, RS}; pg8::gemm_phase(ring, g, S, E); } LSEAM(pb + 9); }
        if (IN(pb + 10)) { _Pragma("unroll 1") for (int rep_ = 0; rep_ < NREP(pb + 10); ++rep_) { PTRS(); pg8::Gemm g; g.A = QM; g.B = (const bf16_t*)(ws + WS_KMEM) + (size_t)l * MEM_T * MEM_W; g.tsA = (size_t)256 * MEM_W * 2; g.pnA = 512; g.tsB = 512; g.pmB = 0; g.rsA = 2048u; g.rsB = 2048u;
            g.hsA = (size_t)128 * 2048; g.hsB = (size_t)128 * 2048; g.nM = 64; g.nN = 4; g.nt = 4; pg8::StaticOrder S; S.init(64, 4, G, bid);
            pg8::EpiSoftmax E{PM, (LAS float*)(F.lds + EPX_OFF)}; pg8::gemm_phase(ring, g, S, E); } LSEAM(pb + 10); }
        if (IN(pb + 11)) { _Pragma("unroll 1") for (int rep_ = 0; rep_ < NREP(pb + 11); ++rep_) { PTRS(); pg8::Gemm g; g.A = PM; g.B = (const bf16_t*)(ws + WS_VMEMT) + (size_t)l * MEM_W * MEM_T; g.tsA = (size_t)256 * MEM_W * 2; g.pnA = 512; g.tsB = 131072; g.pmB = 0; g.rsA = 2048u; g.rsB = 512u;
            g.hsA = (size_t)128 * 2048; g.hsB = 65536; g.nM = 64; g.nN = 4; g.nt = 4; pg8::StaticOrder S; S.init(64, 4, G, bid);
            pg8::EpiStore E{OM, MEM_W, (size_t)256 * MEM_W, 256, nullptr}; pg8::gemm_phase(ring, g, S, E); } SEAM(pb + 11); }
        if (IN(pb + 12)) { _Pragma("unroll 1") for (int rep_ = 0; rep_ < NREP(pb + 12); ++rep_) { PTRS(); pg8::Gemm g = pg8::make_gemm(OM, MEM_W, (const bf16_t*)(wl + WO_MO), MEM_W, SEQ, DM, MEM_W); pg8::StaticOrder S; S.init(g.nM, g.nN, G, bid);
            pg8::EpiStore E{Y, DM, (size_t)256 * DM, 256, nullptr}; pg8::gemm_phase(ring, g, S, E); } SEAM(pb + 12); }
        if (IN(pb + 13)) { _Pragma("unroll 1") for (int rep_ = 0; rep_ < NREP(pb + 13); ++rep_) { PTRS(); resnorm_rows(F, Y, ap->in[20] + (size_t)l * DM, H, (rep_ + 1 < NREP(pb + 13)) ? MERGED : H, (rep_ + 1 < NREP(pb + 13)) ? RS + SEQ : RS, nullptr, ws + WS_XB8, RSQ); } SEAM(pb + 13); }
        if (IN(pb + 14)) { _Pragma("unroll 1") for (int rep_ = 0; rep_ < NREP(pb + 14); ++rep_) { PTRS();
#pragma unroll 1
            for (int hh = 0; hh < UP_SPLIT; ++hh) { constexpr int TPC = 86 / UP_SPLIT;
                pg8::Gemm g; g.A = ws + WS_XB8 - DM; g.B = wl + WO_UP + (size_t)hh * TPC * 256 * DM; g.tsA = (size_t)254 * DM; g.pnA = 0; g.tsB = (size_t)256 * DM; g.pmB = 0; g.rsA = DM; g.rsB = DM;
                g.hsA = (size_t)128 * DM; g.hsB = (size_t)128 * DM; g.nM = 65; g.nN = TPC; g.nt = DM / 128;
                pg8::StaticOrder S; S.init(g.nM, g.nN, G, bid);
                pg8::EpiUpConv E{ACTB, ap->in[29] + (size_t)l * 3 * N_UP, ap->in[30] + (size_t)l * N_UP, RSQ, (const float*)(ws + WS_CS + (size_t)l * CS_LAYER + CS_UP), (LAS float*)(F.lds + EPX_OFF), hh * TPC}; pg8::gemm_phase<pg8::EpiUpConv, 2>(ring, g, S, E);
                if (UP_SPLIT > 1 && hh + 1 < UP_SPLIT && IN(pb + 15)) { XcdBarrier bar_; bar_.bar = (unsigned*)(KARGS()->ws + WS_CTL) + CW_BAR; bar_.x = xb_xcc_id(); bar_.st = (volatile LAS unsigned*)(ring + MISC_OFF) + 8; xcd_barrier(bar_); } }
            } SEAM(pb + 14); }
        if (IN(pb + 16)) { _Pragma("unroll 1") for (int rep_ = 0; rep_ < NREP(pb + 16); ++rep_) { PTRS(); pg8::Gemm g = pg8::make_gemm(ACTB, D_FF, (const bf16_t*)(wl + WO_DOWN), D_FF, SEQ, DM, D_FF); pg8::StaticOrder S; S.init(g.nM, g.nN, G, bid);
            pg8::EpiStore E{Y, DM, (size_t)256 * DM, 256, nullptr}; pg8::gemm_phase(ring, g, S, E); } SEAM(pb + 16); }
        if (IN(pb + 17)) { _Pragma("unroll 1") for (int rep_ = 0; rep_ < NREP(pb + 17); ++rep_) { PTRS(); resnorm_rows(F, Y, ap->in[27] + (size_t)l * DM, H, (rep_ + 1 < NREP(pb + 17)) ? MERGED : H, (rep_ + 1 < NREP(pb + 17)) ? RS + SEQ : RS, l + 1 < DEPTH ? nullptr : X, l + 1 < DEPTH ? ws + WS_XB8 : nullptr, RSQ); } SEAM(pb + 17); }
    }
#if MK_CHECK
    if (hi == N_PHASES) check_finish(ring, ctl, KARGS()->out);
#endif
#undef IN
#undef SEAM
#undef lo
#undef hi
}


static void add_job(Args& a, int& nj, const float* src, int K, int pitch, int n0, int ncols, bf16_t* dst, const float* gain = nullptr) {
    TrJob& j = a.jobs[nj++]; j.src = src; j.dst = dst; j.gain = gain; j.cs = nullptr; j.mode = 0; j.pad = 0; j.K = K; j.pitch = pitch; j.n0 = n0; j.ncols = ncols;
}
extern "C" void kernel_launch(void* const* d_in, const int* in_sizes, int n_in, void* d_out, int out_size, void* d_ws, size_t ws_size, hipStream_t stream) {
    static int grid = 0;
    if (grid == 0) {
        if (n_in != 32 || out_size != SEQ * DM || ws_size < WS_END) { fprintf(stderr, "kernel_launch: unexpected shapes (n_in %d, out %d, ws %zu, need %zu)\n", n_in, out_size, ws_size, (size_t)WS_END); grid = -1; return; }
        int dev = 0, cus = 0, per_cu = 0;
        if (hipGetDevice(&dev) != hipSuccess || hipDeviceGetAttribute(&cus, hipDeviceAttributeMultiprocessorCount, dev) != hipSuccess) { grid = -1; return; }
        if (hipFuncSetAttribute((const void*)enc_fwd, hipFuncAttributeMaxDynamicSharedMemorySize, LDS_BYTES) != hipSuccess) { fprintf(stderr, "kernel_launch: hipFuncSetAttribute failed\n"); grid = -1; return; }
        if (hipOccupancyMaxActiveBlocksPerMultiprocessor(&per_cu, (const void*)enc_fwd, 512, LDS_BYTES) != hipSuccess || per_cu < 1) { fprintf(stderr, "kernel_launch: occupancy query says %d blocks per CU\n", per_cu); (void)hipGetLastError(); grid = -1; return; }
        grid = cus;
    }
    if (grid < 0) return;
    (void)hipMemsetAsync((char*)d_ws + WS_CTL, 0, CTL_BYTES, stream);
    Args a; memset(&a, 0, sizeof(a));
    for (int i = 0; i < 32; ++i) a.in[i] = (const float*)d_in[i];
    a.out = (float*)d_out; a.ws = (unsigned char*)d_ws;
    int nj = 0;
    for (int l = 0; l < DEPTH; ++l) {
        unsigned char* wl = (unsigned char*)d_ws + WS_W + (size_t)l * W_LAYER;
        const float* w_in = a.in[5] + (size_t)l * DM * N_IN; bf16_t* ing = (bf16_t*)(wl + WO_ING);
        const float* g_mix = a.in[3] + (size_t)l * DM; const float* g_mem = a.in[19] + (size_t)l * DM; const float* g_ffn = a.in[26] + (size_t)l * DM;
        unsigned char* q8 = wl + WO_ING + WOI_Q8; float* csq = (float*)((unsigned char*)d_ws + WS_CS + (size_t)l * CS_LAYER);
        constexpr int FB = F_INT8 ? 0 : 1024;
        add_job(a, nj, w_in, DM, N_IN, 1024, 1280, ing + (size_t)FB * DM, g_mix);
        add_job(a, nj, w_in, DM, N_IN, 2304, 64, ing + (size_t)(FB + 1280) * DM, g_mix);
        if (F_INT8) { add_job(a, nj, w_in, DM, N_IN, 0, 1024, (bf16_t*)q8, g_mix); a.jobs[nj - 1].mode = 4; a.jobs[nj - 1].cs = csq; }
        else add_job(a, nj, w_in, DM, N_IN, 0, 1024, ing, g_mix);
        add_job(a, nj, w_in, DM, N_IN, 2368, 4096, (bf16_t*)(q8 + (size_t)(N_ZQ - 4096) * DM), g_mix); a.jobs[nj - 1].mode = 4; a.jobs[nj - 1].cs = csq + (N_ZQ - 4096);
        add_job(a, nj, a.in[16] + (size_t)l * DM * N_GATE, DM, N_GATE, 0, N_GATE, (bf16_t*)(q8 + (size_t)N_ZQ * DM), g_mix); a.jobs[nj - 1].mode = 4; a.jobs[nj - 1].cs = csq + N_ZQ;
        add_job(a, nj, a.in[7] + (size_t)l * Q_LORA * NQ, Q_LORA, NQ, 0, NQ, (bf16_t*)(wl + WO_UQ));
        add_job(a, nj, a.in[9] + (size_t)l * KV_LORA * NKV, KV_LORA, NKV, 0, NKV, (bf16_t*)(wl + WO_UKV));
        add_job(a, nj, a.in[13] + (size_t)l * F_WIDTH * DM, F_WIDTH, DM, 0, DM, (bf16_t*)(wl + WO_BRF));
        add_job(a, nj, a.in[14] + (size_t)l * 1024 * DM, 1024, DM, 0, DM, (bf16_t*)(wl + WO_BRA));
        add_job(a, nj, a.in[15] + (size_t)l * SG_WIDTH * DM, SG_WIDTH, DM, 0, DM, (bf16_t*)(wl + WO_BRS));
        add_job(a, nj, a.in[18] + (size_t)l * DM * DM, DM, DM, 0, DM, (bf16_t*)(wl + WO_OUT));
        add_job(a, nj, a.in[22] + (size_t)l * DM * MEM_W, DM, MEM_W, 0, MEM_W, (bf16_t*)(wl + WO_MQ), g_mem);
        add_job(a, nj, a.in[23] + (size_t)l * DM * MEM_W, DM, MEM_W, 0, MEM_W, (bf16_t*)(wl + WO_MK));
        add_job(a, nj, a.in[24] + (size_t)l * DM * MEM_W, DM, MEM_W, 0, MEM_W, (bf16_t*)(wl + WO_MV));
        add_job(a, nj, a.in[25] + (size_t)l * MEM_W * DM, MEM_W, DM, 0, DM, (bf16_t*)(wl + WO_MO));
        add_job(a, nj, a.in[28] + (size_t)l * DM * N_UP, DM, N_UP, 0, N_UP, (bf16_t*)(wl + WO_UP), g_ffn); a.jobs[nj - 1].mode = 5; a.jobs[nj - 1].cs = (float*)((unsigned char*)d_ws + WS_CS + (size_t)l * CS_LAYER + CS_UP);
        add_job(a, nj, a.in[31] + (size_t)l * D_FF * DM, D_FF, DM, 0, DM, (bf16_t*)(wl + WO_DOWN));
    }
#if MK_N_LAUNCHES == 1
    a.ph_lo = 0; a.ph_hi = N_PHASES;
    hipLaunchKernelGGL(enc_fwd, dim3(grid), dim3(512), LDS_BYTES, stream, a);
#else
    for (int k = 0; k < N_PHASES; ++k) { a.ph_lo = k; a.ph_hi = k + 1; hipLaunchKernelGGL(enc_fwd, dim3(grid), dim3(512), LDS_BYTES, stream, a); }
#endif
    const hipError_t le = hipPeekAtLastError();
    if (le != hipSuccess) fprintf(stderr, "kernel_launch: launch failed: %s\n", hipGetErrorName(le));
}
```

```cpp
#define MK_N_LAUNCHES 1
#include <hip/hip_runtime.h>
#include <cstdio>
#include <cstdint>
#include <cstring>

#ifndef MK_N_LAUNCHES
#define MK_N_LAUNCHES 1
#endif
#ifndef MK_DIGEST
#define MK_DIGEST 0
#endif
#ifndef MK_CHECK
#define MK_CHECK 0
#endif

#define LAS __attribute__((address_space(3)))
#define GAS __attribute__((address_space(1)))
typedef unsigned short bf16_t;
typedef short bf16x8 __attribute__((ext_vector_type(8)));
typedef short s16x4 __attribute__((ext_vector_type(4)));
typedef float f32x2 __attribute__((ext_vector_type(2)));
typedef float f32x4 __attribute__((ext_vector_type(4)));
typedef float f32x8 __attribute__((ext_vector_type(8)));
typedef float f32x16 __attribute__((ext_vector_type(16)));
typedef unsigned u32x2 __attribute__((ext_vector_type(2)));
typedef unsigned u32x4 __attribute__((ext_vector_type(4)));

constexpr int SEQ = 16384, DM = 4096, DEPTH = 2;
constexpr int F_WIDTH = 1024, Q_LORA = 768, KV_LORA = 512, QK_ROPE = 64, SG_WIDTH = 2048;
constexpr int N_IN = 6464, N_INP = 6656;
constexpr int ZC_F = 0, ZC_CQ = 1024, ZC_CKV = 1792, ZC_SGU = 2304, ZC_SGV = 4352, ZC_KR = 6400;
constexpr int N_GATE = 3 * DM, N_ING = N_INP + N_GATE;
#ifndef F_INT8
#define F_INT8 1
#endif
constexpr int N_ZB = F_INT8 ? 1536 : 2560;
constexpr int N_ZQ = F_INT8 ? 5120 : 4096, N_Q8 = N_ZQ + N_GATE;
constexpr int MLA_H = 8, QK_NOPE = 128, V_DIM = 128, DQK = 192;
constexpr int NQ = MLA_H * DQK  , NKV = MLA_H * (QK_NOPE + V_DIM)  ;
constexpr int MEM_T = 256, MEM_W = 1024;
constexpr int D_FF = 11008, N_UP = 2 * D_FF;
constexpr float EPS = 1e-6f;
constexpr float WG8_SCALE = 64.0f;

constexpr size_t MiB = 1u << 20;
constexpr size_t WS_CTL = 0, CTL_BYTES = 65536;
constexpr size_t WS_DRE = 1 * MiB, WS_DIM = WS_DRE + 131072, WS_F1 = WS_DIM + 131072, WS_F3 = WS_F1 + 131072;
constexpr size_t WS_TWC = WS_F3 + 131072, WS_TWS = WS_TWC + 65536;
constexpr size_t WS_ROPEC = 2 * MiB, WS_ROPES = 4 * MiB;
constexpr size_t WS_MEMN = 6 * MiB;
constexpr size_t WS_KMEM = 10 * MiB, WS_VMEMT = 11 * MiB;
constexpr size_t WS_SGW = 12 * MiB;
constexpr size_t WS_RSTD = 13 * MiB;
constexpr size_t WS_RSQ = WS_RSTD + 1 * MiB;
constexpr size_t WS_CS = WS_RSTD + 2 * MiB, CS_LAYER = 262144, CS_UP = 98304;
constexpr size_t WS_W = 17 * MiB, W_LAYER = 507 * MiB;
constexpr size_t WOI_Q8 = 24 * MiB;
constexpr size_t WO_ING = 0, WO_UQ = 148 * MiB, WO_UKV = WO_UQ + 2359296, WO_BRF = 153 * MiB, WO_BRA = 161 * MiB, WO_BRS = 169 * MiB,
                 WO_OUT = 185 * MiB, WO_MQ = 217 * MiB, WO_MK = 225 * MiB, WO_MV = 233 * MiB, WO_MO = 241 * MiB, WO_UP = 249 * MiB, WO_DOWN = 421 * MiB;
static_assert(WO_UKV + 2 * MiB <= WO_BRF && WO_DOWN + 86 * MiB <= W_LAYER, "weight map");
constexpr size_t WS_ACT = WS_W + 2 * W_LAYER;
constexpr size_t WS_H = WS_ACT, WS_Z = WS_H + 128 * MiB, WS_GATES = WS_Z + 208 * MiB, WS_WT1 = WS_GATES + 384 * MiB, WS_S1O = WS_WT1 + 64 * MiB,
                 WS_YF = WS_S1O + 64 * MiB, WS_Q = WS_YF + 32 * MiB, WS_KV = WS_Q + 48 * MiB, WS_OA = WS_KV + 64 * MiB, WS_SGO = WS_OA + 32 * MiB,
                 WS_MERGED = WS_SGO + 64 * MiB, WS_Y = WS_MERGED + 128 * MiB, WS_XB8 = WS_Y + 128 * MiB, WS_END = WS_XB8 + 65 * MiB;
constexpr size_t WS_QM = WS_Z, WS_PM = WS_Z + 32 * MiB, WS_OM = WS_Z + 64 * MiB;
constexpr size_t WS_U = WS_Z, WS_ACTV = WS_U + 688 * MiB;
static_assert(WS_ACTV + 344 * MiB <= WS_Y, "FFN overlay must not reach Y");
constexpr int CW_TMO = 0, CW_CODE = 1, CW_CHK = 64  , CW_BAR = 4096;

constexpr int RING_BYTES = 131072;
constexpr int EPX_OFF = RING_BYTES, EPX_BYTES = 8192;
constexpr int MISC_OFF = EPX_OFF + EPX_BYTES;
constexpr int LDS_BYTES = 147456;

#define RLX_AGENT __ATOMIC_RELAXED, __HIP_MEMORY_SCOPE_AGENT
#define LDS_WAIT() asm volatile("s_waitcnt lgkmcnt(0)" ::: "memory")
#define VM_WAIT() asm volatile("s_waitcnt vmcnt(0)" ::: "memory")
typedef __bf16 bf16v2_t __attribute__((ext_vector_type(2)));
__device__ __forceinline__ unsigned cvt_pk_bf16(float lo, float hi) { const f32x2 v = {lo, hi}; const bf16v2_t r = __builtin_convertvector(v, bf16v2_t); return __builtin_bit_cast(unsigned, r); }
__device__ __forceinline__ float bf2f(unsigned short b) { return __uint_as_float(((unsigned)b) << 16); }
__device__ __forceinline__ float bflo(unsigned w) { return __uint_as_float(w << 16); }
__device__ __forceinline__ float bfhi(unsigned w) { return __uint_as_float(w & 0xffff0000u); }
__device__ __forceinline__ unsigned short f2bf(float f) { return (unsigned short)(cvt_pk_bf16(f, 0.f) & 0xffffu); }
__device__ __forceinline__ float xshfl(int lane, float v, int mask) { return __int_as_float(__builtin_amdgcn_ds_bpermute((lane ^ mask) << 2, __float_as_int(v))); }
__device__ __forceinline__ float wave_sum(int lane, float v) {
#pragma unroll
    for (int o = 1; o < 64; o <<= 1) v += xshfl(lane, v, o);
    return v;
}
__device__ __forceinline__ float wave_max(int lane, float v) {
#pragma unroll
    for (int o = 1; o < 64; o <<= 1) v = fmaxf(v, xshfl(lane, v, o));
    return v;
}
__device__ __forceinline__ unsigned pack_i8x4(float a, float b, float c, float d) {
    const int ia = (int)__builtin_rintf(a), ib = (int)__builtin_rintf(b), ic = (int)__builtin_rintf(c), id = (int)__builtin_rintf(d);
    return ((unsigned)ia & 255u) | (((unsigned)ib & 255u) << 8) | (((unsigned)ic & 255u) << 16) | ((unsigned)id << 24);
}
__device__ __forceinline__ int otid() { int t = threadIdx.x; asm volatile("" : "+v"(t)); return t; }
template <class T> __device__ __forceinline__ T* optr(T* p) { asm volatile("" : "+s"(p)); return p; }
template <class T> __device__ __forceinline__ const __attribute__((address_space(4))) T* optr(const __attribute__((address_space(4))) T* p) { asm volatile("" : "+s"(p)); return p; }
__device__ __forceinline__ float gelu_tanh(float x) {
    const float u = x * (0.7978845608028654f + 0.035677408136300125f * x * x);
    const float e = __builtin_amdgcn_exp2f(-2.885390081777927f * u);
    return x * __builtin_amdgcn_rcpf(1.0f + e);
}
__device__ __forceinline__ float sigmoid_f(float x) { return __builtin_amdgcn_rcpf(1.0f + __builtin_amdgcn_exp2f(-1.4426950408889634f * x)); }

#define XB_TMO      128
#define XB_XCNT(j)  (256  + 64 * (j))
#define XB_XSUB(j)  (1280 + 64 * (j))
#define XB_XGEN(j)  (2304 + 64 * (j))
#define XB_TOP      3328
#define XB_TOPGEN   3392
#define XCD_BAR_WORDS 3456
#define XB_SPIN_CAP (1u << 22)
__device__ __forceinline__ unsigned xb_ld(unsigned* p)              { return __hip_atomic_load(p, __ATOMIC_RELAXED, __HIP_MEMORY_SCOPE_AGENT); }
__device__ __forceinline__ unsigned xb_add(unsigned* p, unsigned v) { return __hip_atomic_fetch_add(p, v, __ATOMIC_RELAXED, __HIP_MEMORY_SCOPE_AGENT); }
__device__ __forceinline__ unsigned xb_xcc_id() { return (unsigned)__builtin_amdgcn_s_getreg((3 << 11) | 20) & 0xFu; }
#define XB_SPIN(cond, bar) do { unsigned _sp = 0; while (cond) { __builtin_amdgcn_s_sleep(1); \
    if ((++_sp & 255u) == 0u) { if (xb_ld(&(bar)[XB_TMO])) break; if (_sp > XB_SPIN_CAP) { atomicAdd(&(bar)[XB_TMO], 1u); break; } } } } while (0)
struct XcdBarrier { unsigned* bar; unsigned x; volatile LAS unsigned* st; };
__device__ __forceinline__ XcdBarrier xcd_barrier_post(unsigned* bar, volatile LAS unsigned* st) {
    XcdBarrier b; b.bar = bar; b.x = xb_xcc_id(); b.st = st;
    if (threadIdx.x == 0) (void)xb_add(&bar[XB_XCNT(b.x)], 1u);
    return b;
}
__device__ __forceinline__ void xcd_barrier_complete(unsigned* bar, unsigned x, unsigned& nloc, unsigned& nx) {
    const unsigned G = gridDim.x * gridDim.y * gridDim.z;
    unsigned sum, cnt, mine, sp = 0u;
    for (;;) {
        sum = 0u; cnt = 0u; mine = 0u;
#pragma unroll
        for (unsigned j = 0; j < 16; ++j) { const unsigned c = xb_ld(&bar[XB_XCNT(j)]); sum += c; cnt += (c > 0u) ? 1u : 0u; mine = (j == x) ? c : mine; }
        if (sum == G) break;
        __builtin_amdgcn_s_sleep(1);
        if ((++sp & 255u) == 0u) { if (xb_ld(&bar[XB_TMO])) break; if (sp > XB_SPIN_CAP) { atomicAdd(&bar[XB_TMO], 1u); break; } }
    }
    nloc = mine > 0u ? mine : 1u; nx = cnt > 0u ? cnt : 1u;
}
__device__ __forceinline__ void xcd_barrier(const XcdBarrier& b) {
    asm volatile("s_waitcnt vmcnt(0)" ::: "memory");
    __syncthreads();
    if (threadIdx.x == 0) {
        unsigned* bar = b.bar;
        __builtin_amdgcn_s_waitcnt(0);
        unsigned nloc = b.st[0], nx = b.st[1];
        if (nloc == 0u) { xcd_barrier_complete(bar, b.x, nloc, nx); b.st[0] = nloc; b.st[1] = nx; }
        const unsigned old = xb_add(&bar[XB_XSUB(b.x)], 1u);
        const unsigned gen = old / nloc;
        if (old + 1u == (gen + 1u) * nloc) {
            __builtin_amdgcn_fence(__ATOMIC_RELEASE, "agent");
            asm volatile("s_waitcnt vmcnt(0)" ::: "memory");
            const unsigned og = xb_add(&bar[XB_TOP], 1u);
            const unsigned tg = og / nx;
            if (og + 1u == (tg + 1u) * nx) xb_add(&bar[XB_TOPGEN], 1u);
            else XB_SPIN(xb_ld(&bar[XB_TOPGEN]) == tg, bar);
            __builtin_amdgcn_fence(__ATOMIC_ACQUIRE, "agent");
            xb_add(&bar[XB_XGEN(b.x)], 1u);
            asm volatile("s_waitcnt vmcnt(0)" ::: "memory");
        } else {
            XB_SPIN(xb_ld(&bar[XB_XGEN(b.x)]) == gen, bar);
            __builtin_amdgcn_fence(__ATOMIC_ACQUIRE, "agent");
            asm volatile("s_waitcnt vmcnt(0)" ::: "memory");
        }
    }
    __syncthreads();
}

#ifndef PG8_SP2
#define PG8_SP2 1
#endif
namespace pg8 {
#ifndef PG8_WGM
#define PG8_WGM 4
#endif
constexpr int BM = 256, BK = 64, HALF = 128, HTB = HALF * BK * 2, STAGE_BYTES = 8 * HTB, NXCD = 8, WGM = PG8_WGM;
__host__ __device__ __forceinline__ int lds_byte(int r, int c) { const int st = (r >> 4) * 2 + (c >> 5), rr = r & 15, cc = c & 31, ob = rr * 64 + cc * 2; return st * 1024 + (ob ^ (((ob >> 9) & 1) << 5)); }
__host__ __device__ __forceinline__ void stage_rc(int b, int& R, int& C) { const int st = b / 1024, sb = b % 1024, swz = sb ^ (((sb >> 9) & 1) << 5); R = (st >> 1) * 16 + swz / 64; C = (st & 1) * 32 + (swz % 64) / 2; }
__host__ __device__ __forceinline__ int perm32(int rho) { const int n = rho >> 4, i = rho & 15; return 8 * (i >> 2) + 4 * n + (i & 3); }
struct Unit { int pm, pn; };
struct Gemm { const void* A; const void* B; size_t tsA, pnA, tsB, pmB; unsigned rsA, rsB; size_t hsA, hsB; int nM, nN, nt; };
__device__ __forceinline__ Gemm make_gemm(const bf16_t* A, int lda, const bf16_t* B, int ldb, int M, int N, int K) {
    Gemm g; g.A = A; g.B = B; g.tsA = (size_t)256 * lda * 2; g.pnA = 0; g.tsB = (size_t)256 * ldb * 2; g.pmB = 0; g.rsA = (unsigned)lda * 2u; g.rsB = (unsigned)ldb * 2u;
    g.hsA = (size_t)128 * lda * 2; g.hsB = (size_t)128 * ldb * 2; g.nM = M / 256; g.nN = N / 256; g.nt = K / 64; return g;
}
struct StaticOrder {
    int nM, nN, nwg, G, c;
    __device__ __forceinline__ void init(int nM_, int nN_, int G_, int c_) { nM = nM_; nN = nN_; nwg = nM * nN; G = G_; c = c_; }
    __device__ __forceinline__ bool unit_of(long L, Unit& u) const {
        if (L < 0 || L >= nwg) return false;
        int wgid = (int)L; { const int q = nwg / NXCD, r = nwg % NXCD, xcd = wgid % NXCD, off = wgid / NXCD; wgid = (xcd < r ? xcd * (q + 1) : r * (q + 1) + (xcd - r) * q) + off; }
        const int nig = WGM * nN, gid = wgid / nig, fm = gid * WGM, gsz = (nM - fm) < WGM ? (nM - fm) : WGM;
        u.pm = fm + ((wgid % nig) % gsz); u.pn = (wgid % nig) / gsz; return true;
    }
    __device__ __forceinline__ bool next(int i, Unit& u) const { return unit_of((long)i * G + c, u); }
};
struct GateOrder : StaticOrder {
    int mode, r0;
    __device__ __forceinline__ long deal(int i) const {
        const int H = G >> 1;
        if (mode == 1) { if (i < r0) return (long)i * G + c; if (c < H || i > r0 + 1) return -1; return (long)r0 * G + (long)(i - r0) * H + (c - H); }
        if (mode == 2) {
            if (i < r0) return (long)i * G + c;
            if (c >= H + 16) { if (i > r0 + 1) return -1; return (long)r0 * G + (long)(i - r0) * (H - 16) + (c - H - 16); }
            if (c < 32 && i == r0) return (long)r0 * G + (long)2 * (H - 16) + c;
            return -1; }
        return (long)i * G + c;
    }
    __device__ __forceinline__ bool next(int i, Unit& u) const { return unit_of(deal(i), u); }
};
typedef int i32x8 __attribute__((ext_vector_type(8)));
typedef int i32x4 __attribute__((ext_vector_type(4)));
__device__ __forceinline__ i32x8 cat8(const bf16x8 lo, const bf16x8 hi) { const u32x4 a = __builtin_bit_cast(u32x4, lo), b = __builtin_bit_cast(u32x4, hi); return (i32x8){(int)a.x, (int)a.y, (int)a.z, (int)a.w, (int)b.x, (int)b.y, (int)b.z, (int)b.w}; }
template <class Epi, int MODE = 0, class Sched = StaticOrder>
__device__ __forceinline__ void gemm_phase(LAS unsigned char* lds, const Gemm g, const Sched& S, const Epi& E) {
    constexpr bool FP8 = (MODE == 1), I8 = (MODE == 2);
    const int tid = otid(), wid = __builtin_amdgcn_readfirstlane(tid >> 6), lane = tid & 63, wr = wid >> 2, wc = wid & 3, fr = lane & 15, fq = lane >> 4;
    const int nt = g.nt;
    unsigned voffA[2], voffB[2];
#pragma unroll
    for (int i = 0; i < 2; ++i) { int R, C; stage_rc(tid * 16 + i * 8192, R, C); const int Rb = (R & ~31) + perm32(R & 31);
        voffA[i] = (unsigned)R * g.rsA + (unsigned)C * 2u; voffB[i] = (unsigned)Rb * g.rsB + (unsigned)C * 2u; }
    const size_t kstep = (size_t)(BK * 2);
    const size_t hsA = g.hsA, hsB = g.hsB;
    const unsigned ldsw = (unsigned)wid * 1024u;
    const int aoff = lds_byte(wr * 64 + fr, fq * 8), boff = lds_byte(wc * 32 + fr, fq * 8);
#define PG8_SA(b, h) (((b) * 2 + (h)) * HTB)
#define PG8_SB(b, h) ((4 + (b) * 2 + (h)) * HTB)
#define PG8_STAGE(bufoff, gbase, voff) do { _Pragma("unroll") for (int _i = 0; _i < 2; ++_i) \
        __builtin_amdgcn_global_load_lds((const unsigned*)((const char*)(gbase) + (voff)[_i]), (LAS unsigned*)(lds + (bufoff) + ldsw + _i * 8192), 16, 0, 0); } while (0)
#define PG8_LDA(dst, b, h) do { if constexpr (FP8) { _Pragma("unroll") for (int m = 0; m < 4; ++m) { const u32x4 lo_ = *(const LAS u32x4*)(lds + PG8_SA(b, h) + aoff + m * 2048), hi_ = *(const LAS u32x4*)(lds + PG8_SA(b, h) + aoff + m * 2048 + 1024); \
            dst##8[m] = __builtin_bit_cast(i32x8, __builtin_shufflevector(lo_, hi_, 0, 1, 2, 3, 4, 5, 6, 7)); } } \
        else { _Pragma("unroll") for (int m = 0; m < 4; ++m) _Pragma("unroll") for (int k = 0; k < 2; ++k) dst[m][k] = *(const LAS bf16x8*)(lds + PG8_SA(b, h) + aoff + m * 2048 + k * 1024); } } while (0)
#define PG8_LDB(dst, b, h) do { if constexpr (FP8) { _Pragma("unroll") for (int n = 0; n < 2; ++n) { const u32x4 lo_ = *(const LAS u32x4*)(lds + PG8_SB(b, h) + boff + n * 2048), hi_ = *(const LAS u32x4*)(lds + PG8_SB(b, h) + boff + n * 2048 + 1024); \
            dst##8[n] = __builtin_bit_cast(i32x8, __builtin_shufflevector(lo_, hi_, 0, 1, 2, 3, 4, 5, 6, 7)); } } \
        else { _Pragma("unroll") for (int n = 0; n < 2; ++n) _Pragma("unroll") for (int k = 0; k < 2; ++k) dst[n][k] = *(const LAS bf16x8*)(lds + PG8_SB(b, h) + boff + n * 2048 + k * 1024); } } while (0)
#define PG8_MMA(ai, bj, At, Bt) do { __builtin_amdgcn_s_setprio(1); \
        if constexpr (FP8) { _Pragma("unroll") for (int m = 0; m < 4; ++m) _Pragma("unroll") for (int n = 0; n < 2; ++n) \
            asm volatile("v_mfma_scale_f32_16x16x128_f8f6f4 %0, %1, %2, %0, %3, %3 op_sel_hi:[0,0,0]" : "+v"(acc[ai][bj][m][n]) : "v"(Bt##8[n]), "v"(At##8[m]), "v"(one_scale)); } \
        else if constexpr (I8) { _Pragma("unroll") for (int m = 0; m < 4; ++m) _Pragma("unroll") for (int n = 0; n < 2; ++n) _Pragma("unroll") for (int k = 0; k < 2; ++k) \
            acc[ai][bj][m][n] = __builtin_bit_cast(f32x4, __builtin_amdgcn_mfma_i32_16x16x64_i8(__builtin_bit_cast(i32x4, Bt[n][k]), __builtin_bit_cast(i32x4, At[m][k]), __builtin_bit_cast(i32x4, acc[ai][bj][m][n]), 0, 0, 0)); } \
        else { _Pragma("unroll") for (int m = 0; m < 4; ++m) _Pragma("unroll") for (int n = 0; n < 2; ++n) _Pragma("unroll") for (int k = 0; k < 2; ++k) \
            acc[ai][bj][m][n] = __builtin_amdgcn_mfma_f32_16x16x32_bf16(Bt[n][k], At[m][k], acc[ai][bj][m][n], 0, 0, 0); } \
        __builtin_amdgcn_s_setprio(0); } while (0)
#define PG8_WAIT_V(n) asm volatile("s_waitcnt vmcnt(" #n ")" ::: "memory")
#define PG8_WAIT_L(n) asm volatile("s_waitcnt lgkmcnt(" #n ")" ::: "memory")
#define PG8_BAR __builtin_amdgcn_s_barrier()
#define PG8_SCHED __builtin_amdgcn_sched_barrier(0)
    Unit cur, nxt; int ui = 0;
    if (!S.next(0, cur)) return;
    f32x4 acc[2][2][4][2];
#pragma unroll
    for (int a = 0; a < 2; ++a)
#pragma unroll
        for (int b = 0; b < 2; ++b)
#pragma unroll
            for (int m = 0; m < 4; ++m)
#pragma unroll
                for (int n = 0; n < 2; ++n) acc[a][b][m][n] = (f32x4){0.f, 0.f, 0.f, 0.f};
    int one_scale = 0x7F7F7F7F; asm volatile("" : "+v"(one_scale));
    bf16x8 At[4][2], B0[2][2], B1[2][2]; i32x8 At8[4], B08[2], B18[2]; (void)At; (void)B0; (void)B1; (void)At8; (void)B08; (void)B18;
    const char* cA = (const char*)g.A + (size_t)cur.pm * g.tsA + (size_t)cur.pn * g.pnA; const char* cB = (const char*)g.B + (size_t)cur.pn * g.tsB + (size_t)cur.pm * g.pmB;
#if PG8_SP2
    PG8_STAGE(PG8_SB(0, 0), cB, voffB); PG8_STAGE(PG8_SB(0, 1), cB + hsB, voffB); PG8_STAGE(PG8_SA(0, 0), cA, voffA); PG8_STAGE(PG8_SA(0, 1), cA + hsA, voffA);
    if (wr == 1) PG8_BAR;
    PG8_WAIT_V(2); PG8_BAR;
    PG8_STAGE(PG8_SB(1, 0), cB + kstep, voffB); PG8_STAGE(PG8_SA(1, 0), cA + kstep, voffA); PG8_STAGE(PG8_SB(1, 1), cB + hsB + kstep, voffB);
    PG8_WAIT_V(6); PG8_BAR;
#else
    PG8_STAGE(PG8_SB(0, 0), cB, voffB); PG8_STAGE(PG8_SA(0, 0), cA, voffA); PG8_STAGE(PG8_SB(0, 1), cB + hsB, voffB); PG8_STAGE(PG8_SA(0, 1), cA + hsA, voffA);
    if (wr == 1) PG8_BAR;
    PG8_WAIT_V(4); PG8_BAR;
    PG8_STAGE(PG8_SB(1, 0), cB + kstep, voffB); PG8_STAGE(PG8_SA(1, 0), cA + kstep, voffA); PG8_STAGE(PG8_SB(1, 1), cB + hsB + kstep, voffB);
    PG8_WAIT_V(6); PG8_BAR;
#endif
    for (;;) {
        const bool has_next = S.next(ui + 1, nxt);
        const char* nA = has_next ? (const char*)g.A + (size_t)nxt.pm * g.tsA + (size_t)nxt.pn * g.pnA : cA;
        const char* nB = has_next ? (const char*)g.B + (size_t)nxt.pn * g.tsB + (size_t)nxt.pm * g.pmB : cB;
        for (int t = 0; t < nt; t += 2) {
            const bool last = (t == nt - 2);
            const char* a1 = cA + (size_t)(t + 1) * kstep;
            const char* a2 = last ? nA : cA + (size_t)(t + 2) * kstep; const char* b2 = last ? nB : cB + (size_t)(t + 2) * kstep;
            const char* a3 = a2 + kstep; const char* b3 = b2 + kstep;
#if PG8_SP2
            PG8_LDB(B0, 0, 0); PG8_LDB(B1, 0, 1); PG8_SCHED; PG8_LDA(At, 0, 0); PG8_STAGE(PG8_SA(1, 1), a1 + hsA, voffA);
            PG8_WAIT_V(8); PG8_WAIT_L(0); PG8_BAR; PG8_MMA(0, 0, At, B0); PG8_MMA(0, 1, At, B1); PG8_BAR; PG8_SCHED;
            PG8_LDA(At, 0, 1); PG8_STAGE(PG8_SB(0, 0), b2, voffB); PG8_STAGE(PG8_SB(0, 1), b2 + hsB, voffB); PG8_STAGE(PG8_SA(0, 0), a2, voffA);
            PG8_WAIT_V(8); PG8_WAIT_L(0); PG8_BAR; PG8_MMA(1, 0, At, B0); PG8_MMA(1, 1, At, B1); PG8_BAR; PG8_SCHED;
            PG8_LDB(B0, 1, 0); PG8_LDB(B1, 1, 1); PG8_SCHED; PG8_LDA(At, 1, 0); PG8_STAGE(PG8_SA(0, 1), a2 + hsA, voffA);
            PG8_WAIT_V(8); PG8_WAIT_L(0); PG8_BAR; PG8_MMA(0, 0, At, B0); PG8_MMA(0, 1, At, B1); PG8_BAR; PG8_SCHED;
            PG8_LDA(At, 1, 1); PG8_STAGE(PG8_SB(1, 0), b3, voffB); PG8_STAGE(PG8_SB(1, 1), b3 + hsB, voffB); PG8_STAGE(PG8_SA(1, 0), a3, voffA);
            PG8_WAIT_V(8); PG8_WAIT_L(0); PG8_BAR; PG8_MMA(1, 0, At, B0); PG8_MMA(1, 1, At, B1); PG8_BAR; PG8_SCHED;
#else
            PG8_LDB(B0, 0, 0); PG8_SCHED; PG8_LDA(At, 0, 0); PG8_STAGE(PG8_SA(1, 1), a1 + hsA, voffA);
            PG8_WAIT_L(8); PG8_BAR; PG8_WAIT_L(0); PG8_MMA(0, 0, At, B0); PG8_BAR; PG8_SCHED;
            PG8_LDB(B1, 0, 1); PG8_STAGE(PG8_SB(0, 0), b2, voffB);
            PG8_BAR; PG8_WAIT_L(0); PG8_MMA(0, 1, At, B1); PG8_BAR;
            PG8_LDA(At, 0, 1); PG8_STAGE(PG8_SA(0, 0), a2, voffA);
            PG8_BAR; PG8_WAIT_L(0); PG8_MMA(1, 0, At, B0); PG8_BAR; PG8_SCHED;
            PG8_STAGE(PG8_SB(0, 1), b2 + hsB, voffB);
            PG8_WAIT_V(6); PG8_BAR; PG8_MMA(1, 1, At, B1); PG8_BAR;
            PG8_LDB(B0, 1, 0); PG8_SCHED; PG8_LDA(At, 1, 0); PG8_STAGE(PG8_SA(0, 1), a2 + hsA, voffA);
            PG8_WAIT_L(8); PG8_BAR; PG8_WAIT_L(0); PG8_MMA(0, 0, At, B0); PG8_BAR; PG8_SCHED;
            PG8_LDB(B1, 1, 1); PG8_STAGE(PG8_SB(1, 0), b3, voffB);
            PG8_BAR; PG8_WAIT_L(0); PG8_MMA(0, 1, At, B1); PG8_BAR;
            PG8_LDA(At, 1, 1); PG8_STAGE(PG8_SA(1, 0), a3, voffA);
            PG8_BAR; PG8_WAIT_L(0); PG8_MMA(1, 0, At, B0); PG8_BAR; PG8_SCHED;
            PG8_STAGE(PG8_SB(1, 1), b3 + hsB, voffB);
            PG8_WAIT_V(6); PG8_BAR; PG8_MMA(1, 1, At, B1); PG8_BAR;
#endif
        }
        if (wr == 0) PG8_BAR;
        if constexpr (FP8) asm volatile("s_nop 15\n\ts_nop 15" ::: "memory");
        if constexpr (I8) {
#pragma unroll
            for (int a = 0; a < 2; ++a)
#pragma unroll
                for (int b = 0; b < 2; ++b)
#pragma unroll
                    for (int m = 0; m < 4; ++m)
#pragma unroll
                        for (int n = 0; n < 2; ++n) acc[a][b][m][n] = __builtin_convertvector(__builtin_bit_cast(i32x4, acc[a][b][m][n]), f32x4);
        }
        E(acc, cur, wr, wc, fr, fq);
        if (!has_next) break;
#pragma unroll
        for (int a = 0; a < 2; ++a)
#pragma unroll
            for (int b = 0; b < 2; ++b)
#pragma unroll
                for (int m = 0; m < 4; ++m)
#pragma unroll
                    for (int n = 0; n < 2; ++n) acc[a][b][m][n] = (f32x4){0.f, 0.f, 0.f, 0.f};
        cur = nxt; cA = nA; cB = nB; ++ui;
        if (wr == 1) PG8_BAR;
    }
    PG8_WAIT_V(0);
    PG8_BAR;
#undef PG8_SA
#undef PG8_SB
#undef PG8_STAGE
#undef PG8_LDA
#undef PG8_LDB
#undef PG8_MMA
#undef PG8_WAIT_V
#undef PG8_WAIT_L
#undef PG8_BAR
#undef PG8_SCHED
}
}
#ifndef PROBE_DOUBLE_STORE
#define PROBE_DOUBLE_STORE 0
#endif
namespace pg8 {
__device__ __forceinline__ u32x4 pack8(const f32x4 v0, const f32x4 v1) {
    u32x4 w; w.x = cvt_pk_bf16(v0[0], v0[1]); w.y = cvt_pk_bf16(v0[2], v0[3]); w.z = cvt_pk_bf16(v1[0], v1[1]); w.w = cvt_pk_bf16(v1[2], v1[3]); return w;
}
struct EpiStore {
    bf16_t* O; int ldc; size_t tsO, pnO; const float* rs;
    __device__ __forceinline__ void operator()(const f32x4 (&acc)[2][2][4][2], const Unit& u, int wr, int wc, int fr, int fq) const {
        asm volatile("" : "+v"(fr), "+v"(fq));
        bf16_t* base = O + (size_t)u.pm * tsO + (size_t)u.pn * pnO + (size_t)(wr * 64 + fr) * ldc + wc * 32 + 8 * fq;
#pragma unroll
        for (int ai = 0; ai < 2; ++ai)
#pragma unroll
            for (int m = 0; m < 4; ++m) { bf16_t* rowp = base + (size_t)(ai * HALF + m * 16) * ldc;
                const float sc = rs ? rs[u.pm * BM + ai * HALF + wr * 64 + m * 16 + fr] : 1.0f;
#pragma unroll
                for (int bj = 0; bj < 2; ++bj) { const u32x4 w_ = pack8(acc[ai][bj][m][0] * sc, acc[ai][bj][m][1] * sc); *(u32x4*)(rowp + bj * HALF) = w_;
#if PROBE_DOUBLE_STORE
                    asm volatile("" ::: "memory"); *(u32x4*)(rowp + bj * HALF) = w_;
#endif
                } }
    }
};
struct EpiZB {
    bf16_t* Z; const float* rs;
    __device__ __forceinline__ void operator()(const f32x4 (&acc)[2][2][4][2], const Unit& u, int wr, int wc, int fr, int fq) const {
        asm volatile("" : "+v"(fr), "+v"(fq));
        const int row0 = u.pm * BM + wr * 64 + fr;
        bf16_t* base = Z + (size_t)row0 * N_INP + (u.pn < N_ZB / BM - 1 ? (F_INT8 ? ZC_CQ : 0) + u.pn * BM : ZC_KR) + wc * 32 + 8 * fq;
#pragma unroll
        for (int ai = 0; ai < 2; ++ai)
#pragma unroll
            for (int m = 0; m < 4; ++m) { bf16_t* rowp = base + (size_t)(ai * HALF + m * 16) * N_INP; const float sc = rs[row0 + ai * HALF + m * 16];
#pragma unroll
                for (int bj = 0; bj < 2; ++bj) *(u32x4*)(rowp + bj * HALF) = pack8(acc[ai][bj][m][0] * sc, acc[ai][bj][m][1] * sc); }
    }
};
struct EpiInQ {
    bf16_t* Z; bf16_t* G; const float* bgate; const float* rs; const float* cs;
    __device__ __forceinline__ void operator()(const f32x4 (&acc)[2][2][4][2], const Unit& u, int wr, int wc, int fr, int fq) const {
        asm volatile("" : "+v"(fr), "+v"(fq));
        const int row0 = u.pm * BM + wr * 64 + fr, cl = wc * 32 + 8 * fq;
        f32x4 cv[2][2];
#pragma unroll
        for (int bj = 0; bj < 2; ++bj)
#pragma unroll
            for (int n = 0; n < 2; ++n) cv[bj][n] = *(const f32x4*)(cs + u.pn * BM + cl + bj * HALF + 4 * n);
        constexpr int NF = F_INT8 ? 4 : 0;
        if (u.pn < NF + 16) {
            const bool act = u.pn >= NF;
            bf16_t* base = Z + (size_t)row0 * N_INP + (act ? ZC_SGU + (u.pn - NF) * BM : u.pn * BM) + cl;
#pragma unroll
            for (int ai = 0; ai < 2; ++ai)
#pragma unroll
                for (int m = 0; m < 4; ++m) { bf16_t* rowp = base + (size_t)(ai * HALF + m * 16) * N_INP; const float sc = rs[row0 + ai * HALF + m * 16];
#pragma unroll
                    for (int bj = 0; bj < 2; ++bj) { f32x4 v0 = (acc[ai][bj][m][0] * sc) * cv[bj][0], v1 = (acc[ai][bj][m][1] * sc) * cv[bj][1];
                        if (act) {
#pragma unroll
                            for (int j = 0; j < 4; ++j) { v0[j] = gelu_tanh(v0[j]); v1[j] = gelu_tanh(v1[j]); } }
                        *(u32x4*)(rowp + bj * HALF) = pack8(v0, v1); } }
        } else {
            const int gc = (u.pn - NF - 16) * BM + cl;
            bf16_t* base = G + (size_t)row0 * N_GATE + gc;
            f32x4 bv[2][2];
#pragma unroll
            for (int bj = 0; bj < 2; ++bj)
#pragma unroll
                for (int n = 0; n < 2; ++n) bv[bj][n] = *(const f32x4*)(bgate + gc + bj * HALF + 4 * n);
#pragma unroll
            for (int ai = 0; ai < 2; ++ai)
#pragma unroll
                for (int m = 0; m < 4; ++m) { bf16_t* rowp = base + (size_t)(ai * HALF + m * 16) * N_GATE; const float sc = rs[row0 + ai * HALF + m * 16];
#pragma unroll
                    for (int bj = 0; bj < 2; ++bj) { f32x4 v0 = (acc[ai][bj][m][0] * sc) * cv[bj][0] + bv[bj][0], v1 = (acc[ai][bj][m][1] * sc) * cv[bj][1] + bv[bj][1];
#pragma unroll
                        for (int j = 0; j < 4; ++j) { v0[j] = sigmoid_f(v0[j]); v1[j] = sigmoid_f(v1[j]); }
                        *(u32x4*)(rowp + bj * HALF) = pack8(v0, v1); } }
        }
    }
};
struct EpiMerge {
    bf16_t* M; const bf16_t* G; int first;
    __device__ __forceinline__ void operator()(const f32x4 (&acc)[2][2][4][2], const Unit& u, int wr, int wc, int fr, int fq) const {
        asm volatile("" : "+v"(fr), "+v"(fq));
        const int row0 = u.pm * BM + wr * 64 + fr, col0 = u.pn * BM + wc * 32 + 8 * fq;
#pragma unroll
        for (int ai = 0; ai < 2; ++ai) {
            u32x4 gw[4][2], pw[4][2];
#pragma unroll
            for (int m = 0; m < 4; ++m)
#pragma unroll
                for (int bj = 0; bj < 2; ++bj) { const size_t r = (size_t)(row0 + ai * HALF + m * 16);
                    gw[m][bj] = *(const u32x4*)(G + r * N_GATE + col0 + bj * HALF);
                    pw[m][bj] = (u32x4){0u, 0u, 0u, 0u}; if (!first) pw[m][bj] = *(const u32x4*)(M + r * DM + col0 + bj * HALF); }
#pragma unroll
            for (int m = 0; m < 4; ++m)
#pragma unroll
                for (int bj = 0; bj < 2; ++bj) { const size_t r = (size_t)(row0 + ai * HALF + m * 16); const u32x4 g = gw[m][bj], p = pw[m][bj];
                    f32x4 v0 = acc[ai][bj][m][0], v1 = acc[ai][bj][m][1];
                    v0[0] = bflo(p.x) + bflo(g.x) * v0[0]; v0[1] = bfhi(p.x) + bfhi(g.x) * v0[1]; v0[2] = bflo(p.y) + bflo(g.y) * v0[2]; v0[3] = bfhi(p.y) + bfhi(g.y) * v0[3];
                    v1[0] = bflo(p.z) + bflo(g.z) * v1[0]; v1[1] = bfhi(p.z) + bfhi(g.z) * v1[1]; v1[2] = bflo(p.w) + bflo(g.w) * v1[2]; v1[3] = bfhi(p.w) + bfhi(g.w) * v1[3];
                    *(u32x4*)(M + r * DM + col0 + bj * HALF) = pack8(v0, v1); }
            asm volatile("" ::: "memory");
        }
    }
};
struct EpiCD {
    bf16_t* WT1; int ri;
    __device__ __forceinline__ void operator()(const f32x4 (&acc)[2][2][4][2], const Unit& u, int wr, int wc, int fr, int fq) const {
        asm volatile("" : "+v"(fr), "+v"(fq));
#pragma unroll
        for (int ai = 0; ai < 2; ++ai)
#pragma unroll
            for (int m = 0; m < 4; ++m) { const int c = u.pm * 256 + ai * HALF + wr * 64 + m * 16 + fr;
#pragma unroll
                for (int bj = 0; bj < 2; ++bj) { const int b = 2 * u.pn + bj, a = wc * 32 + 8 * fq;
                    *(u32x4*)(WT1 + ((size_t)(c * 128 + b) * 2 + ri) * 128 + a) = pack8(acc[ai][bj][m][0], acc[ai][bj][m][1]); } }
    }
};
struct EpiS1 {
    bf16_t* S1O; const float* twc; const float* tws;
    __device__ __forceinline__ void operator()(const f32x4 (&acc)[2][2][4][2], const Unit& u, int wr, int wc, int fr, int fq) const {
        asm volatile("" : "+v"(fr), "+v"(fq));
#pragma unroll
        for (int m = 0; m < 4; ++m) { const int k2 = wr * 64 + m * 16 + fr, b0 = wc * 32 + 8 * fq;
            const f32x4 c0 = *(const f32x4*)(twc + k2 * 128 + b0), c1 = *(const f32x4*)(twc + k2 * 128 + b0 + 4), s0 = *(const f32x4*)(tws + k2 * 128 + b0), s1 = *(const f32x4*)(tws + k2 * 128 + b0 + 4);
#pragma unroll
            for (int bj = 0; bj < 2; ++bj) { const int c = 2 * u.pn + bj;
                const f32x4 re0 = acc[0][bj][m][0], re1 = acc[0][bj][m][1], im0 = acc[1][bj][m][0], im1 = acc[1][bj][m][1];
                const f32x4 ar0 = re0 * c0 + im0 * s0, ar1 = re1 * c1 + im1 * s1, ai0 = im0 * c0 - re0 * s0, ai1 = im1 * c1 - re1 * s1;
                bf16_t* p = S1O + ((size_t)(k2 * 1024 + c) * 2) * 128 + b0;
                *(u32x4*)p = pack8(ar0, ar1); *(u32x4*)(p + 128) = pack8(ai0, ai1); }
            asm volatile("" ::: "memory"); }
    }
};
struct EpiS3 {
    bf16_t* YF;
    __device__ __forceinline__ void operator()(const f32x4 (&acc)[2][2][4][2], const Unit& u, int wr, int wc, int fr, int fq) const {
        asm volatile("" : "+v"(fr), "+v"(fq));
        const int k2 = u.pn >> 2, c0 = (u.pn & 3) * 256 + wc * 32 + 8 * fq;
#pragma unroll
        for (int m = 0; m < 4; ++m) { const int k1 = wr * 64 + m * 16 + fr; bf16_t* rowp = YF + (size_t)(128 * k1 + k2) * 1024 + c0;
#pragma unroll
            for (int bj = 0; bj < 2; ++bj) *(u32x4*)(rowp + bj * HALF) = pack8(acc[0][bj][m][0], acc[0][bj][m][1]); }
    }
};
struct EpiSoftmax {
    bf16_t* P; LAS float* ex;
    __device__ __forceinline__ void operator()(const f32x4 (&acc)[2][2][4][2], const Unit& u, int wr, int wc, int fr, int fq) const {
        asm volatile("" : "+v"(fr), "+v"(fq));
        constexpr float C = 0.0625f * 1.4426950408889634f;
        float mx[2][4];
#pragma unroll
        for (int ai = 0; ai < 2; ++ai)
#pragma unroll
            for (int m = 0; m < 4; ++m) { float v = -3.0e38f;
#pragma unroll
                for (int bj = 0; bj < 2; ++bj)
#pragma unroll
                    for (int n = 0; n < 2; ++n) { const f32x4 x = acc[ai][bj][m][n]; v = fmaxf(v, fmaxf(fmaxf(x[0], x[1]), fmaxf(x[2], x[3]))); }
                v = fmaxf(v, xshfl(fr + 16 * fq, v, 16)); v = fmaxf(v, xshfl(fr + 16 * fq, v, 32));
                if (fq == 0) ex[(ai * HALF + wr * 64 + m * 16 + fr) * 4 + wc] = v; }
        LDS_WAIT(); __builtin_amdgcn_s_barrier(); asm volatile("" ::: "memory");
#pragma unroll
        for (int ai = 0; ai < 2; ++ai)
#pragma unroll
            for (int m = 0; m < 4; ++m) { const f32x4 t = *(const LAS f32x4*)(ex + (ai * HALF + wr * 64 + m * 16 + fr) * 4);
                const float M = fmaxf(fmaxf(t[0], t[1]), fmaxf(t[2], t[3])), mC = -M * C; float s = 0.f;
#pragma unroll
                for (int bj = 0; bj < 2; ++bj)
#pragma unroll
                    for (int n = 0; n < 2; ++n)
#pragma unroll
                        for (int j = 0; j < 4; ++j) s += __builtin_amdgcn_exp2f(fmaf(acc[ai][bj][m][n][j], C, mC));
                s += xshfl(fr + 16 * fq, s, 16); s += xshfl(fr + 16 * fq, s, 32);
                if (fq == 0) ex[1024 + (ai * HALF + wr * 64 + m * 16 + fr) * 4 + wc] = s; asm volatile("" ::: "memory"); }
        LDS_WAIT(); __builtin_amdgcn_s_barrier(); asm volatile("" ::: "memory");
        bf16_t* base = P + (size_t)(u.pm * BM + wr * 64 + fr) * MEM_W + u.pn * BM + wc * 32 + 8 * fq;
#pragma unroll
        for (int ai = 0; ai < 2; ++ai)
#pragma unroll
            for (int m = 0; m < 4; ++m) { const int rr = (ai * HALF + wr * 64 + m * 16 + fr) * 4;
                const f32x4 t = *(const LAS f32x4*)(ex + rr), ts = *(const LAS f32x4*)(ex + 1024 + rr);
                const float M = fmaxf(fmaxf(t[0], t[1]), fmaxf(t[2], t[3])), mC = -M * C;
                const float inv = __builtin_amdgcn_rcpf((ts[0] + ts[1]) + (ts[2] + ts[3])); bf16_t* rowp = base + (size_t)(ai * HALF + m * 16) * MEM_W;
#pragma unroll
                for (int bj = 0; bj < 2; ++bj) { f32x4 v0, v1;
#pragma unroll
                    for (int j = 0; j < 4; ++j) { v0[j] = __builtin_amdgcn_exp2f(fmaf(acc[ai][bj][m][0][j], C, mC)) * inv; v1[j] = __builtin_amdgcn_exp2f(fmaf(acc[ai][bj][m][1][j], C, mC)) * inv; }
                    *(u32x4*)(rowp + bj * HALF) = pack8(v0, v1); }
                asm volatile("" ::: "memory"); }
    }
};
struct EpiUpConv {
    bf16_t* ACT; const float* cw; const float* cb; const float* rs; const float* cs; LAS float* ex; int pn0;
    static __device__ __forceinline__ float dshr1(float old, float src) { return __int_as_float(__builtin_amdgcn_update_dpp(__float_as_int(old), __float_as_int(src), 0x111, 0xf, 0xf, false)); }
    static __device__ __forceinline__ float dshl1(float old, float src) { return __int_as_float(__builtin_amdgcn_update_dpp(__float_as_int(old), __float_as_int(src), 0x101, 0xf, 0xf, false)); }
    static __device__ __forceinline__ float dror1(float src)  { return __int_as_float(__builtin_amdgcn_mov_dpp(__float_as_int(src), 0x121, 0xf, 0xf, true)); }
    static __device__ __forceinline__ float dror15(float src) { return __int_as_float(__builtin_amdgcn_mov_dpp(__float_as_int(src), 0x12F, 0xf, 0xf, true)); }
    __device__ __forceinline__ void operator()(f32x4 (&acc)[2][2][4][2], const Unit& u, int wr, int wc, int fr, int fq) const {
        asm volatile("" : "+v"(fr), "+v"(fq));
        const int r0 = 254 * u.pm - 1;
        const int ecol = wc * 32 + 8 * fq;
        float scl[2][4]; bool okr[2][4];
#pragma unroll
        for (int ai = 0; ai < 2; ++ai)
#pragma unroll
            for (int m = 0; m < 4; ++m) { const int gr = r0 + ai * HALF + wr * 64 + m * 16 + fr; okr[ai][m] = gr >= 0 && gr < SEQ; scl[ai][m] = rs[okr[ai][m] ? gr : 0]; }
#pragma unroll
        for (int ai = 0; ai < 2; ++ai)
#pragma unroll
            for (int m = 0; m < 4; ++m) { const bool ok = okr[ai][m]; const float sc = scl[ai][m];
                if (u.pm > 0 && u.pm < 64) {
#pragma unroll
                    for (int bj = 0; bj < 2; ++bj)
#pragma unroll
                        for (int n = 0; n < 2; ++n) acc[ai][bj][m][n] = acc[ai][bj][m][n] * sc;
                } else {
#pragma unroll
                    for (int bj = 0; bj < 2; ++bj)
#pragma unroll
                        for (int n = 0; n < 2; ++n)
#pragma unroll
                            for (int j = 0; j < 4; ++j) acc[ai][bj][m][n][j] = ok ? acc[ai][bj][m][n][j] * sc : 0.f; } }
#pragma unroll
        for (int ai = 0; ai < 2; ++ai)
#pragma unroll
            for (int bj = 0; bj < 2; ++bj)
#pragma unroll
                for (int n = 0; n < 2; ++n) {
                    if (fr == 0)  *(LAS f32x4*)(ex + ((((wr * 2 + ai) * 2 + 0) * 2 + bj) * 128) + ecol + 4 * n) = acc[ai][bj][0][n];
                    if (fr == 15) *(LAS f32x4*)(ex + ((((wr * 2 + ai) * 2 + 1) * 2 + bj) * 128) + ecol + 4 * n) = acc[ai][bj][3][n]; }
        LDS_WAIT(); __builtin_amdgcn_s_barrier(); asm volatile("" ::: "memory");
#pragma unroll
        for (int n = 0; n < 2; ++n) {
            const int c0 = (u.pn + pn0) * 128 + ecol + 4 * n;
            const f32x4 csg = *(const f32x4*)(cs + (u.pn + pn0) * 256 + ecol + 4 * n), csv = *(const f32x4*)(cs + (u.pn + pn0) * 256 + 128 + ecol + 4 * n);
            const f32x4 wg0 = *(const f32x4*)(cw + c0) * csg, wg1 = *(const f32x4*)(cw + N_UP + c0) * csg, wg2 = *(const f32x4*)(cw + 2 * N_UP + c0) * csg, bg = *(const f32x4*)(cb + c0);
            const f32x4 wv0 = *(const f32x4*)(cw + D_FF + c0) * csv, wv1 = *(const f32x4*)(cw + N_UP + D_FF + c0) * csv, wv2 = *(const f32x4*)(cw + 2 * N_UP + D_FF + c0) * csv, bv = *(const f32x4*)(cb + D_FF + c0);
#pragma unroll
            for (int ai = 0; ai < 2; ++ai) {
                const f32x4 z4 = (f32x4){0.f, 0.f, 0.f, 0.f};
                f32x4 tg = z4, tv = z4, xg = z4, xv = z4;
                if (wr == 1 || ai == 1) { const int swr = wr == 1 ? 0 : 1, sai = wr == 1 ? ai : 0;
                    tg = *(const LAS f32x4*)(ex + ((((swr * 2 + sai) * 2 + 1) * 2 + 0) * 128) + ecol + 4 * n); tv = *(const LAS f32x4*)(ex + ((((swr * 2 + sai) * 2 + 1) * 2 + 1) * 128) + ecol + 4 * n); }
                if (wr == 0 || ai == 0) { const int swr = wr == 0 ? 1 : 0, sai = wr == 0 ? ai : 1;
                    xg = *(const LAS f32x4*)(ex + ((((swr * 2 + sai) * 2 + 0) * 2 + 0) * 128) + ecol + 4 * n); xv = *(const LAS f32x4*)(ex + ((((swr * 2 + sai) * 2 + 0) * 2 + 1) * 128) + ecol + 4 * n); }
#pragma unroll
                for (int m = 0; m < 4; ++m) {
                    float o[4];
#pragma unroll
                    for (int j = 0; j < 4; ++j) {
                        const float cg = acc[ai][0][m][n][j], cv = acc[ai][1][m][n][j];
                        const float pg = m > 0 ? dror1(acc[ai][0][m > 0 ? m - 1 : 0][n][j]) : tg[j], pv = m > 0 ? dror1(acc[ai][1][m > 0 ? m - 1 : 0][n][j]) : tv[j];
                        const float ng = m < 3 ? dror15(acc[ai][0][m < 3 ? m + 1 : 3][n][j]) : xg[j], nv = m < 3 ? dror15(acc[ai][1][m < 3 ? m + 1 : 3][n][j]) : xv[j];
                        const float ug = dshr1(pg, cg), uv = dshr1(pv, cv), dg = dshl1(ng, cg), dv = dshl1(nv, cv);
                        const float gc = fmaf(wg0[j], ug, fmaf(wg1[j], cg, fmaf(wg2[j], dg, bg[j])));
                        const float vc = fmaf(wv0[j], uv, fmaf(wv1[j], cv, fmaf(wv2[j], dv, bv[j])));
                        o[j] = gelu_tanh(gc) * vc; }
                    const int r = ai * HALF + wr * 64 + m * 16 + fr, gr = r0 + r;
                    if (r >= 1 && r <= 254 && gr < SEQ) { u32x2 w; w.x = cvt_pk_bf16(o[0], o[1]); w.y = cvt_pk_bf16(o[2], o[3]); *(u32x2*)(ACT + (size_t)gr * D_FF + c0) = w; }
                }
            }
        }
    }
};
}
struct Frame { LAS unsigned char* lds; int tid, lane, wave, G, bid; };
__device__ __forceinline__ Frame make_frame(LAS unsigned char* lds) { Frame F; F.lds = lds; F.tid = otid(); F.lane = F.tid & 63; F.wave = __builtin_amdgcn_readfirstlane(F.tid >> 6); F.G = gridDim.x; F.bid = blockIdx.x; return F; }
struct TrJob { const float* src; bf16_t* dst; const float* gain; float* cs; int K, pitch, n0, ncols, mode, pad; };
constexpr int NJOBS = 34;
struct Args {
    const float* in[32]; float* out; unsigned char* ws;
    TrJob jobs[NJOBS];
    int ph_lo, ph_hi; int pad0, pad1;
};

__device__ __forceinline__ void norm_rows(const Frame& F, const float* X, const float* gain, bf16_t* H, int nrows) {
    for (int m = F.bid * 8 + F.wave; m < nrows; m += F.G * 8) {
        const f32x4* xr = (const f32x4*)(X + (size_t)m * DM) + F.lane;
        f32x4 v[16]; float ss = 0.f;
#pragma unroll
        for (int j = 0; j < 16; ++j) { v[j] = xr[64 * j]; ss += (v[j][0] * v[j][0] + v[j][1] * v[j][1]) + (v[j][2] * v[j][2] + v[j][3] * v[j][3]); }
        const float rstd = rsqrtf(wave_sum(F.lane, ss) * (1.0f / DM) + EPS);
        u32x2* o = (u32x2*)(H + (size_t)m * DM) + F.lane;
#pragma unroll
        for (int j = 0; j < 16; ++j) { const f32x4 g = ((const f32x4*)gain)[64 * j + F.lane]; const f32x4 y = v[j] * rstd * g;
            u32x2 w; w.x = cvt_pk_bf16(y[0], y[1]); w.y = cvt_pk_bf16(y[2], y[3]); o[64 * j] = w; }
    }
}
__device__ __forceinline__ unsigned pack_fp8x4(float a, float b, float c, float d) { int w = 0; w = __builtin_amdgcn_cvt_pk_fp8_f32(a, b, w, false); w = __builtin_amdgcn_cvt_pk_fp8_f32(c, d, w, true); return (unsigned)w; }
__device__ __forceinline__ void xb_rows(const Frame& F, const float* X, bf16_t* XB, float* RS, unsigned char* XB8, float* RSQ) {
    for (int m = F.bid * 8 + F.wave; m < SEQ; m += F.G * 8) {
        const f32x4* xr = (const f32x4*)(X + (size_t)m * DM) + F.lane;
        f32x4 v[16]; float ss = 0.f, am = 0.f;
#pragma unroll
        for (int j = 0; j < 16; ++j) { v[j] = xr[64 * j]; ss += (v[j][0] * v[j][0] + v[j][1] * v[j][1]) + (v[j][2] * v[j][2] + v[j][3] * v[j][3]); }
        const float rstd = rsqrtf(wave_sum(F.lane, ss) * (1.0f / DM) + EPS);
        u32x2* o = (u32x2*)(XB + (size_t)m * DM) + F.lane;
#pragma unroll
        for (int j = 0; j < 16; ++j) { u32x2 w; w.x = cvt_pk_bf16(v[j][0], v[j][1]); w.y = cvt_pk_bf16(v[j][2], v[j][3]); o[64 * j] = w;
            v[j] = (f32x4){bflo(w.x), bfhi(w.x), bflo(w.y), bfhi(w.y)};
            am = fmaxf(fmaxf(am, fmaxf(fabsf(v[j][0]), fabsf(v[j][1]))), fmaxf(fabsf(v[j][2]), fabsf(v[j][3]))); }
        am = wave_max(F.lane, am);
        const float inv = am > 0.f ? 127.0f / am : 0.f;
#pragma unroll
        for (int j = 0; j < 16; ++j) ((unsigned*)(XB8 + (size_t)m * DM))[64 * j + F.lane] = pack_i8x4(v[j][0] * inv, v[j][1] * inv, v[j][2] * inv, v[j][3] * inv);
        if (F.lane == 0) { RS[m] = rstd; RSQ[m] = rstd * am * (1.0f / (127.0f * 127.0f)); }
    }
}
__device__ __forceinline__ void rn_issue(u32x2 (&xb)[16], const bf16_t* Y, const bf16_t* XB, int m, int lane, LAS unsigned char* ybuf) {
    const char* yr = (const char*)(Y + (size_t)m * DM) + lane * 16;
#pragma unroll
    for (int j = 0; j < 8; ++j) __builtin_amdgcn_global_load_lds((const unsigned*)(yr + j * 1024), (LAS unsigned*)(ybuf + j * 1024), 16, 0, 0);
    const u32x2* xr = (const u32x2*)(XB + (size_t)m * DM) + lane;
#pragma unroll
    for (int j = 0; j < 16; ++j) xb[j] = xr[64 * j];
}
__device__ __forceinline__ void rn_process(const u32x2 (&xb)[16], u32x2 (&y)[16], const LAS float* gpost, bf16_t* XB, float* RS, float* OUT32, unsigned char* XB8, float* RSQ, int m, int lane) {
    float ss = 0.f;
#pragma unroll
    for (int j = 0; j < 16; ++j) { const float a = bflo(y[j].x), c = bfhi(y[j].x), d = bflo(y[j].y), e = bfhi(y[j].y); ss += (a * a + c * c) + (d * d + e * e); }
    const float rstd = rsqrtf(wave_sum(lane, ss) * (1.0f / DM) + EPS);
    float s2 = 0.f, am = 0.f;
#pragma unroll
    for (int j = 0; j < 16; ++j) { const f32x4 g = ((const LAS f32x4*)gpost)[64 * j + lane]; const f32x4 yv = (f32x4){bflo(y[j].x), bfhi(y[j].x), bflo(y[j].y), bfhi(y[j].y)};
        const f32x4 xo = (f32x4){bflo(xb[j].x), bfhi(xb[j].x), bflo(xb[j].y), bfhi(xb[j].y)};
        const f32x4 xn = xo + yv * rstd * g; s2 += (xn[0] * xn[0] + xn[1] * xn[1]) + (xn[2] * xn[2] + xn[3] * xn[3]);
        if (OUT32) ((f32x4*)(OUT32 + (size_t)m * DM))[64 * j + lane] = xn;
        else { u32x2 w; w.x = cvt_pk_bf16(xn[0], xn[1]); w.y = cvt_pk_bf16(xn[2], xn[3]); ((u32x2*)(XB + (size_t)m * DM))[64 * j + lane] = w;
            if (XB8) { y[j] = w;
                am = fmaxf(fmaxf(am, fmaxf(fabsf(bflo(w.x)), fabsf(bfhi(w.x)))), fmaxf(fabsf(bflo(w.y)), fabsf(bfhi(w.y)))); } } }
    if (!OUT32) { const float rstd2 = rsqrtf(wave_sum(lane, s2) * (1.0f / DM) + EPS); if (lane == 0) RS[m] = rstd2;
        if (XB8) { am = wave_max(lane, am); const float inv = am > 0.f ? 127.0f / am : 0.f;
#pragma unroll
            for (int j = 0; j < 16; ++j) ((unsigned*)(XB8 + (size_t)m * DM))[64 * j + lane] = pack_i8x4(bflo(y[j].x) * inv, bfhi(y[j].x) * inv, bflo(y[j].y) * inv, bfhi(y[j].y) * inv);
            if (lane == 0) RSQ[m] = rstd2 * am * (1.0f / (127.0f * 127.0f)); } }
}
__device__ __forceinline__ void resnorm_rows(const Frame& F, const bf16_t* Y, const float* gpost, const bf16_t* XBin, bf16_t* XB, float* RS, float* OUT32, unsigned char* XB8, float* RSQ) {
    const int step = F.G * 8; int m = F.bid * 8 + F.wave;
    LAS unsigned char* ybuf = F.lds + F.wave * 8192;
    LAS float* gl = (LAS float*)(F.lds + 65536);
    __syncthreads();
    for (int i = F.tid; i < DM / 4; i += 512) ((LAS f32x4*)gl)[i] = ((const f32x4*)gpost)[i];
    __syncthreads();
    u32x2 xa[16], xb2[16], y[16];
    if (m < SEQ) rn_issue(xa, Y, XBin, m, F.lane, ybuf);
#define RN_TAKE_Y() do { asm volatile("s_waitcnt vmcnt(0)" ::: "memory"); _Pragma("unroll") for (int j = 0; j < 16; ++j) y[j] = *(const LAS u32x2*)(ybuf + j * 512 + F.lane * 8); \
        asm volatile("s_waitcnt lgkmcnt(0)" ::: "memory"); } while (0)
    while (m < SEQ) {
        const int m1 = m + step, m2 = m + 2 * step;
        RN_TAKE_Y();
        if (m1 < SEQ) rn_issue(xb2, Y, XBin, m1, F.lane, ybuf);
        rn_process(xa, y, gl, XB, RS, OUT32, XB8, RSQ, m, F.lane);
        if (m1 >= SEQ) break;
        RN_TAKE_Y();
        if (m2 < SEQ) rn_issue(xa, Y, XBin, m2, F.lane, ybuf);
        rn_process(xb2, y, gl, XB, RS, OUT32, XB8, RSQ, m1, F.lane);
        m = m2;
    }
#undef RN_TAKE_Y
    asm volatile("s_waitcnt vmcnt(0)" ::: "memory");
    __syncthreads();
}
__device__ __forceinline__ void prep_rows(const Frame& F, bf16_t* Z, const float* gq, const float* gkv, const float* ropec, const float* ropes) {
    for (int m = F.bid * 8 + F.wave; m < SEQ; m += F.G * 8) {
        bf16_t* zr = Z + (size_t)m * N_INP;
        {   u32x2* p = (u32x2*)(zr + ZC_CQ) + F.lane; f32x4 v[3]; float ss = 0.f;
#pragma unroll
            for (int j = 0; j < 3; ++j) { const u32x2 w = p[64 * j]; v[j] = (f32x4){bflo(w.x), bfhi(w.x), bflo(w.y), bfhi(w.y)}; ss += (v[j][0] * v[j][0] + v[j][1] * v[j][1]) + (v[j][2] * v[j][2] + v[j][3] * v[j][3]); }
            const float rstd = rsqrtf(wave_sum(F.lane, ss) * (1.0f / Q_LORA) + EPS);
#pragma unroll
            for (int j = 0; j < 3; ++j) { const f32x4 g = ((const f32x4*)gq)[64 * j + F.lane]; const f32x4 y = v[j] * rstd * g; u32x2 w; w.x = cvt_pk_bf16(y[0], y[1]); w.y = cvt_pk_bf16(y[2], y[3]); p[64 * j] = w; } }
        {   u32x2* p = (u32x2*)(zr + ZC_CKV) + F.lane; f32x4 v[2]; float ss = 0.f;
#pragma unroll
            for (int j = 0; j < 2; ++j) { const u32x2 w = p[64 * j]; v[j] = (f32x4){bflo(w.x), bfhi(w.x), bflo(w.y), bfhi(w.y)}; ss += (v[j][0] * v[j][0] + v[j][1] * v[j][1]) + (v[j][2] * v[j][2] + v[j][3] * v[j][3]); }
            const float rstd = rsqrtf(wave_sum(F.lane, ss) * (1.0f / KV_LORA) + EPS);
#pragma unroll
            for (int j = 0; j < 2; ++j) { const f32x4 g = ((const f32x4*)gkv)[64 * j + F.lane]; const f32x4 y = v[j] * rstd * g; u32x2 w; w.x = cvt_pk_bf16(y[0], y[1]); w.y = cvt_pk_bf16(y[2], y[3]); p[64 * j] = w; } }
        if (F.lane < 32) { bf16_t* kr = zr + ZC_KR; const float t1 = bf2f(kr[F.lane]), t2 = bf2f(kr[32 + F.lane]); const float c = ropec[(size_t)m * 32 + F.lane], s = ropes[(size_t)m * 32 + F.lane];
            kr[F.lane] = f2bf(t1 * c - t2 * s); kr[32 + F.lane] = f2bf(t2 * c + t1 * s); }
    }
}
__device__ __forceinline__ void transpose_item(const float* W, int pitch, int K, bf16_t* WT, const float* gain, const float* cs, int mode, LAS float* scr, int kb, int nb, int lane) {
    const int k0 = 64 * kb, n0 = 32 * nb;
    const int d0 = (mode & 1) ? ((n0 % D_FF) / 128) * 256 + (n0 >= D_FF ? 128 : 0) + (n0 % 128) : n0;
#pragma unroll 8
    for (int i = 0; i < 32; ++i) { const int kk = 2 * i + (lane >> 5); scr[kk * 33 + (lane & 31)] = W[(size_t)(k0 + kk) * pitch + n0 + (lane & 31)]; }
    LDS_WAIT(); asm volatile("" ::: "memory");
    const int c = lane & 7;
    f32x4 ga = (f32x4){1.f, 1.f, 1.f, 1.f}, gb = ga; if (gain) { ga = *(const f32x4*)(gain + k0 + 8 * c); gb = *(const f32x4*)(gain + k0 + 8 * c + 4); }
#pragma unroll
    for (int j = 0; j < 4; ++j) { const int n = (lane >> 3) + 8 * j; const LAS float* s = scr + (8 * c) * 33 + n;
        u32x4 o; o.x = cvt_pk_bf16(s[0 * 33] * ga[0], s[1 * 33] * ga[1]); o.y = cvt_pk_bf16(s[2 * 33] * ga[2], s[3 * 33] * ga[3]); o.z = cvt_pk_bf16(s[4 * 33] * gb[0], s[5 * 33] * gb[1]); o.w = cvt_pk_bf16(s[6 * 33] * gb[2], s[7 * 33] * gb[3]);
        if (mode & 4) {
            const float am = cs[d0 + n], inv = am > 0.f ? 127.0f / am : 0.f;
            const unsigned w0 = pack_i8x4(s[0 * 33] * ga[0] * inv, s[1 * 33] * ga[1] * inv, s[2 * 33] * ga[2] * inv, s[3 * 33] * ga[3] * inv);
            const unsigned w1 = pack_i8x4(s[4 * 33] * gb[0] * inv, s[5 * 33] * gb[1] * inv, s[6 * 33] * gb[2] * inv, s[7 * 33] * gb[3] * inv);
            *(u32x2*)((unsigned char*)WT + (size_t)(d0 + n) * K + k0 + 8 * c) = (u32x2){w0, w1}; }
        else if (mode == 2) {
            int w0 = 0, w1 = 0;
            w0 = __builtin_amdgcn_cvt_pk_fp8_f32(s[0 * 33] * ga[0] * WG8_SCALE, s[1 * 33] * ga[1] * WG8_SCALE, w0, false); w0 = __builtin_amdgcn_cvt_pk_fp8_f32(s[2 * 33] * ga[2] * WG8_SCALE, s[3 * 33] * ga[3] * WG8_SCALE, w0, true);
            w1 = __builtin_amdgcn_cvt_pk_fp8_f32(s[4 * 33] * gb[0] * WG8_SCALE, s[5 * 33] * gb[1] * WG8_SCALE, w1, false); w1 = __builtin_amdgcn_cvt_pk_fp8_f32(s[6 * 33] * gb[2] * WG8_SCALE, s[7 * 33] * gb[3] * WG8_SCALE, w1, true);
            *(u32x2*)((unsigned char*)WT + (size_t)(d0 + n) * K + k0 + 8 * c) = (u32x2){(unsigned)w0, (unsigned)w1}; }
        else *(u32x4*)(WT + (size_t)(d0 + n) * K + k0 + 8 * c) = o; }
    LDS_WAIT(); asm volatile("" ::: "memory");
}
__device__ __forceinline__ bool q_locate(const __attribute__((address_space(4))) Args* ap, int T, int& jo, int& so) {
    for (int j = 0; j < NJOBS; ++j) { if (!(ap->jobs[j].mode & 4)) continue; const int n = ap->jobs[j].ncols / 16; if (T < n) { jo = j; so = T; return true; } T -= n; }
    return false;
}
__device__ __forceinline__ void quant_jobs(const Frame& F, const __attribute__((address_space(4))) Args* ap) {
    constexpr int CP = 8208;
    LAS unsigned char* stg = F.lds; LAS float* red = (LAS float*)(F.lds + 16 * CP);
    const int c = F.lane & 15, kp = F.lane >> 4, kw0 = F.wave * 512 + 2 * kp;
    int T, step;
    if ((F.G & 15) == 0) { const int x = F.bid & 7, r = F.bid >> 3; T = 2 * (x + 8 * (r >> 1)) + (r & 1); step = F.G; }
    else { T = F.bid; step = F.G; }
    float R[128];
#define Q_ISSUE(J, ST) do { const float* p_ = ap->jobs[J].src + ap->jobs[J].n0 + (size_t)kw0 * ap->jobs[J].pitch + 16 * (ST) + c; const size_t pitch_ = (size_t)ap->jobs[J].pitch; \
        _Pragma("unroll") for (int i = 0; i < 64; ++i) { R[2 * i] = p_[(size_t)(8 * i) * pitch_]; R[2 * i + 1] = p_[(size_t)(8 * i + 1) * pitch_]; } } while (0)
    int j = 0, st = 0; bool have = q_locate(ap, T, j, st);
    if (have) Q_ISSUE(j, st);
    while (have) {
        const float* gain = ap->jobs[j].gain; float* cs = ap->jobs[j].cs; unsigned char* dst = (unsigned char*)ap->jobs[j].dst; const int mode = ap->jobs[j].mode;
        const float* gp = gain + kw0;
        LAS unsigned char* sp = stg + c * CP + kw0 * 2;
        float mx = 0.f;
#pragma unroll
        for (int i = 0; i < 64; ++i) { const float g0 = gain ? gp[8 * i] : 1.0f, g1 = gain ? gp[8 * i + 1] : 1.0f;
            const unsigned pk = cvt_pk_bf16(R[2 * i] * g0, R[2 * i + 1] * g1); mx = fmaxf(mx, fmaxf(fabsf(bflo(pk)), fabsf(bfhi(pk))));
            *(LAS unsigned*)(sp + 16 * i) = pk; }
        mx = fmaxf(mx, xshfl(F.lane, mx, 16)); mx = fmaxf(mx, xshfl(F.lane, mx, 32));
        if (F.lane < 16) red[F.wave * 16 + c] = mx;
        __syncthreads();
        int jn = 0, sn = 0; const bool hn = q_locate(ap, T + step, jn, sn);
        if (hn) Q_ISSUE(jn, sn);
#pragma unroll
        for (int cc = 0; cc < 2; ++cc) { const int col = 2 * F.wave + cc; float am = red[col];
#pragma unroll
            for (int w = 1; w < 8; ++w) am = fmaxf(am, red[w * 16 + col]);
            const float inv = am > 0.f ? 127.0f / am : 0.f;
            const int n = 16 * st + col; const int d = (mode & 1) ? ((n % D_FF) / 128) * 256 + (n >= D_FF ? 128 : 0) + (n % 128) : n;
            unsigned char* orow = dst + (size_t)d * DM;
#pragma unroll
            for (int q = 0; q < 8; ++q) { const u32x4 a = *(const LAS u32x4*)(stg + col * CP + (q * 64 + F.lane) * 16);
                u32x2 o; o.x = pack_i8x4(bflo(a.x) * inv, bfhi(a.x) * inv, bflo(a.y) * inv, bfhi(a.y) * inv); o.y = pack_i8x4(bflo(a.z) * inv, bfhi(a.z) * inv, bflo(a.w) * inv, bfhi(a.w) * inv);
                *(u32x2*)(orow + (q * 64 + F.lane) * 8) = o; }
            if (F.lane == 0) cs[d] = am; }
        __syncthreads();
        T += step; j = jn; st = sn; have = hn;
    }
#undef Q_ISSUE
}
__device__ __forceinline__ void prologue_phase(const Frame& F, const __attribute__((address_space(4))) Args* ap) {
    unsigned char* ws = ap->ws;
    LAS float* scr = (LAS float*)(F.lds + F.wave * 16384);
    const int gw = F.bid * 8 + F.wave, NGW = F.G * 8;
    quant_jobs(F, ap);
    for (int j = 0; j < NJOBS; ++j) { if (ap->jobs[j].mode & 4) continue;
        TrJob jb; jb.src = ap->jobs[j].src; jb.dst = ap->jobs[j].dst; jb.gain = ap->jobs[j].gain; jb.cs = ap->jobs[j].cs; jb.mode = ap->jobs[j].mode; jb.K = ap->jobs[j].K; jb.pitch = ap->jobs[j].pitch; jb.n0 = ap->jobs[j].n0; jb.ncols = ap->jobs[j].ncols; const int nblk = jb.ncols / 32, nit = (jb.K / 64) * nblk;
        const float* src = jb.src + jb.n0;
        for (int it = gw; it < nit; it += NGW) transpose_item(src, jb.pitch, jb.K, jb.dst, jb.gain, jb.cs, jb.mode, scr, it / nblk, it % nblk, F.lane);
    }
    const int gt = F.bid * 512 + F.tid, NGT = F.G * 512;
    for (int l = 0; l < DEPTH; ++l) { u32x4* p = (u32x4*)(ws + WS_W + (size_t)l * W_LAYER + WO_ING + (size_t)(N_ZB - (N_INP - N_IN)) * DM * 2);
        for (int i = gt; i < (N_INP - N_IN) * DM * 2 / 16; i += NGT) p[i] = (u32x4){0u, 0u, 0u, 0u}; }
    bf16_t* dre = (bf16_t*)(ws + WS_DRE); bf16_t* dim = (bf16_t*)(ws + WS_DIM); bf16_t* f1 = (bf16_t*)(ws + WS_F1); bf16_t* f3 = (bf16_t*)(ws + WS_F3);
    for (int i = gt; i < 65536; i += NGT) { const int r = i >> 8, c = i & 255;
        { const float x = 2.0f * (float)((r * c) & 255) * (1.0f / 256.0f); dre[i] = f2bf(cospif(x) * 0.0625f); dim[i] = f2bf(-sinpif(x) * 0.0625f); }
        { const int k2 = r & 127, rip = r >> 7, aa = c & 127, ri = c >> 7; const float x = 2.0f * (float)((k2 * aa) & 127) * (1.0f / 128.0f); const float cs = cospif(x) * 0.08838834764831845f, sn = sinpif(x) * 0.08838834764831845f;
          f1[i] = f2bf(rip == ri ? cs : (rip == 0 ? sn : -sn));
          f3[i] = f2bf(r < 128 ? (ri == 0 ? cs : sn) : 0.f); } }
    float* twc = (float*)(ws + WS_TWC); float* tws = (float*)(ws + WS_TWS);
    for (int i = gt; i < 16384; i += NGT) { const int k2 = i >> 7, b = i & 127; const float x = 2.0f * (float)(k2 * b) * (1.0f / 16384.0f); twc[i] = cospif(x); tws[i] = sinpif(x); }
    float* rc = (float*)(ws + WS_ROPEC); float* rs = (float*)(ws + WS_ROPES); const int* pos = (const int*)ap->in[2];
    for (int i = gt; i < SEQ * 32; i += NGT) { const int m = i >> 5, k = i & 31; const float inv = powf(10000.0f, -(float)(2 * k) / 64.0f); const float ang = (float)pos[m] * inv; rc[i] = cosf(ang); rs[i] = sinf(ang); }
    { const float* wsp = ap->in[11]; bf16_t* sgw = (bf16_t*)(ws + WS_SGW);
      for (int i = gt; i < DEPTH * 16 * 128 * 128 / 2; i += NGT) { const f32x2 v = ((const f32x2*)wsp)[i]; ((unsigned*)sgw)[i] = cvt_pk_bf16(v[0], v[1]); } }
    for (int l = 0; l < DEPTH; ++l) norm_rows(F, ap->in[1], ap->in[21] + (size_t)l * DM, (bf16_t*)(ws + WS_MEMN) + (size_t)l * MEM_T * DM, MEM_T);
    xb_rows(F, ap->in[0], (bf16_t*)(ws + WS_H), (float*)(ws + WS_RSTD), ws + WS_XB8, (float*)(ws + WS_RSQ));
}

__device__ __forceinline__ void sg_phase(const Frame& F, const bf16_t* Z, const bf16_t* sgw, const float* lng, const float* bsp, bf16_t* SGO) {
    constexpr int VTP = 272;
    LAS unsigned char* vt = F.lds;
    const int t = F.tid, q = t >> 2, sub = t & 3, lane = F.lane, r32 = lane & 31, hi = lane >> 5, pblk = F.wave >> 1, dh = F.wave & 1;
    for (int u = F.bid; u < 128 * 16; u += F.G) {
        const int ck = u >> 4, g = u & 15;
        __syncthreads();
        {   const bf16_t* vrow = Z + (size_t)(ck * 128 + q) * N_INP + ZC_SGV + g * 128;
            float x[4][8]; float s = 0.f;
#pragma unroll
            for (int i = 0; i < 4; ++i) { const u32x4 w = *(const u32x4*)(vrow + (sub + 4 * i) * 8);
#pragma unroll
                for (int j = 0; j < 4; ++j) { x[i][2 * j] = bflo(w[j]); x[i][2 * j + 1] = bfhi(w[j]); s += x[i][2 * j] + x[i][2 * j + 1]; } }
            s += xshfl(lane, s, 1); s += xshfl(lane, s, 2);
            const float mu = s * (1.0f / 128.0f); float qq = 0.f;
#pragma unroll
            for (int i = 0; i < 4; ++i)
#pragma unroll
                for (int j = 0; j < 8; ++j) { x[i][j] -= mu; qq += x[i][j] * x[i][j]; }
            qq += xshfl(lane, qq, 1); qq += xshfl(lane, qq, 2);
            const float rstd = rsqrtf(qq * (1.0f / 128.0f) + EPS);
#pragma unroll
            for (int i = 0; i < 4; ++i) { const int d0 = (sub + 4 * i) * 8;
                const f32x4 g0 = *(const f32x4*)(lng + g * 128 + d0), g1 = *(const f32x4*)(lng + g * 128 + d0 + 4);
#pragma unroll
                for (int j = 0; j < 8; ++j) { const float y = x[i][j] * rstd * (j < 4 ? g0[j & 3] : g1[j & 3]);
                    *(LAS bf16_t*)(vt + (d0 + j) * VTP + q * 2) = f2bf(y); } }
        }
        __syncthreads();
        f32x16 acc0 = {}, acc1 = {};
        const bf16_t* wrow = sgw + ((size_t)g * 128 + pblk * 32 + r32) * 128 + hi * 8;
        const LAS unsigned char* a0p = vt + ((dh * 2 + 0) * 32 + r32) * VTP + hi * 16;
        const LAS unsigned char* a1p = vt + ((dh * 2 + 1) * 32 + r32) * VTP + hi * 16;
#pragma unroll
        for (int ks = 0; ks < 8; ++ks) {
            const bf16x8 bw = *(const bf16x8*)(wrow + ks * 16);
            const bf16x8 a0 = *(const LAS bf16x8*)(a0p + ks * 32), a1 = *(const LAS bf16x8*)(a1p + ks * 32);
            acc0 = __builtin_amdgcn_mfma_f32_32x32x16_bf16(a0, bw, acc0, 0, 0, 0);
            acc1 = __builtin_amdgcn_mfma_f32_32x32x16_bf16(a1, bw, acc1, 0, 0, 0);
        }
        const int p = pblk * 32 + r32; const float bp = bsp[g * 128 + p];
        const bf16_t* urow = Z + (size_t)(ck * 128 + p) * N_INP + ZC_SGU + g * 128;
        bf16_t* orow = SGO + (size_t)(ck * 128 + p) * SG_WIDTH + g * 128;
#pragma unroll
        for (int db = 0; db < 2; ++db)
#pragma unroll
            for (int rg = 0; rg < 4; ++rg) { const int d0 = (dh * 2 + db) * 32 + 8 * rg + 4 * hi;
                const u32x2 uw = *(const u32x2*)(urow + d0);
                const float s0 = (db ? acc1[4 * rg + 0] : acc0[4 * rg + 0]) + bp, s1 = (db ? acc1[4 * rg + 1] : acc0[4 * rg + 1]) + bp, s2 = (db ? acc1[4 * rg + 2] : acc0[4 * rg + 2]) + bp, s3 = (db ? acc1[4 * rg + 3] : acc0[4 * rg + 3]) + bp;
                u32x2 w; w.x = cvt_pk_bf16(bflo(uw.x) * s0, bfhi(uw.x) * s1); w.y = cvt_pk_bf16(bflo(uw.y) * s2, bfhi(uw.y) * s3);
                *(u32x2*)(orow + d0) = w; }
    }
    __syncthreads();
}
#ifndef ATT_ILV
#define ATT_ILV 0
#endif
namespace att {
constexpr int NW = 8, QBLK = 32, KVBLK = 64;
constexpr float SCALE = 0.07216878364870322f;
#ifndef ATT_THR
#define ATT_THR 8.f
#endif
constexpr float THR = ATT_THR;
constexpr int SHM_V = 16384, SHM_KN = 16384, SHM_KR = 8192;
constexpr int OFF_V = 0, OFF_KN = 2 * SHM_V, OFF_KR = OFF_KN + 2 * SHM_KN, OFF_WS = OFF_KR + 2 * SHM_KR, ATT_LDS = OFF_WS + NW * 64 * 4;
#define KNSWZ(row, colB) ((row) * 256 + ((colB) ^ (((row) & 15) << 4)))
#define KRSWZ(row, colB) ((row) * 128 + ((colB) ^ ((((row) >> 1) & 7) << 4)))
#define SBAR() __builtin_amdgcn_sched_barrier(0)
#if ATT_ILV
#define QK_ILV() do { _Pragma("unroll") for (int i_ = 0; i_ < 24; ++i_) { __builtin_amdgcn_sched_group_barrier(0x008, 1, 0); __builtin_amdgcn_sched_group_barrier(0x100, 2, 0); __builtin_amdgcn_sched_group_barrier(0x002, ATT_ILV, 0); } } while (0)
#else
#define QK_ILV() do { } while (0)
#endif
__device__ __forceinline__ int crow(int r, int hi) { return (r & 3) + 8 * (r >> 2) + 4 * hi; }
__device__ __forceinline__ void partialSM(f32x16& p0, f32x16& p1, float& m_reg, float& mn, float& alpha) {
    constexpr float C = SCALE * 1.4426950408889634f;
    float pmax = p0[0];
#pragma unroll
    for (int r = 1; r < 16; ++r) pmax = fmaxf(pmax, p0[r]);
#pragma unroll
    for (int r = 0; r < 16; ++r) pmax = fmaxf(pmax, p1[r]);
    { auto rr = __builtin_amdgcn_permlane32_swap(__float_as_uint(pmax), __float_as_uint(pmax), false, false);
      pmax = fmaxf(__uint_as_float(rr[0]), __uint_as_float(rr[1])); }
    if (__builtin_expect(__all(pmax - m_reg <= THR / SCALE), 1)) { mn = m_reg; alpha = 1.f; }
    else { mn = fmaxf(m_reg, pmax); alpha = __builtin_amdgcn_exp2f((m_reg - mn) * C); m_reg = mn; }
    const float mnC = -mn * C;
#pragma unroll
    for (int r = 0; r < 16; ++r) p0[r] = fmaf(p0[r], C, mnC);
#pragma unroll
    for (int r = 0; r < 16; ++r) p1[r] = fmaf(p1[r], C, mnC);
#pragma unroll
    for (int r = 0; r < 16; ++r) p0[r] = __builtin_amdgcn_exp2f(p0[r]);
}
__device__ __forceinline__ void finishSM(f32x16& p0, f32x16& p1, float alpha, float& l_reg, bf16x8& pa0, bf16x8& pa1, bf16x8& pa2, bf16x8& pa3) {
#pragma unroll
    for (int r = 0; r < 16; ++r) p1[r] = __builtin_amdgcn_exp2f(p1[r]);
    float ps = 0;
#pragma unroll
    for (int r = 0; r < 16; ++r) ps += p0[r];
#pragma unroll
    for (int r = 0; r < 16; ++r) ps += p1[r];
    { auto rr = __builtin_amdgcn_permlane32_swap(__float_as_uint(ps), __float_as_uint(ps), false, false);
      ps = __uint_as_float(rr[0]) + __uint_as_float(rr[1]); }
    l_reg = l_reg * alpha + ps;
#define PK4(P, BASE, OUT) do { unsigned a0 = cvt_pk_bf16(P[BASE + 0], P[BASE + 1]), a1 = cvt_pk_bf16(P[BASE + 2], P[BASE + 3]);   \
    unsigned b0 = cvt_pk_bf16(P[BASE + 4], P[BASE + 5]), b1 = cvt_pk_bf16(P[BASE + 6], P[BASE + 7]);                              \
    auto r0 = __builtin_amdgcn_permlane32_swap(a0, b0, false, false); auto r1 = __builtin_amdgcn_permlane32_swap(a1, b1, false, false); \
    u32x4 w = {r0[0], r1[0], r0[1], r1[1]}; OUT = *reinterpret_cast<bf16x8*>(&w); } while (0)
    PK4(p0, 0, pa0); PK4(p0, 8, pa1); PK4(p1, 0, pa2); PK4(p1, 8, pa3);
#undef PK4
}
#ifndef ATT_QKPIPE
#define ATT_QKPIPE 1
#endif
#define SB_ALU() __builtin_amdgcn_sched_barrier(0x0002 | 0x0004 | 0x0400)
__device__ __forceinline__ void qkt(f32x16& p0, f32x16& p1, const LAS unsigned char* Kn, const LAS unsigned char* Kr, const bf16x8 (&qr)[12], int r32, int hi) {
    p0 = f32x16{}; p1 = f32x16{};
#define KRD(s, half) ((s) < 8 ? *(const LAS bf16x8*)(Kn + KNSWZ(32 * (half) + r32, ((s) * 16 + hi * 8) * 2)) : *(const LAS bf16x8*)(Kr + KRSWZ(32 * (half) + r32, (((s) - 8) * 16 + hi * 8) * 2)))
#if ATT_QKPIPE == 0
#pragma unroll
    for (int s = 0; s < 12; ++s) { const bf16x8 b0 = KRD(s, 0), b1 = KRD(s, 1);
        p0 = __builtin_amdgcn_mfma_f32_32x32x16_bf16(b0, qr[s], p0, 0, 0, 0); p1 = __builtin_amdgcn_mfma_f32_32x32x16_bf16(b1, qr[s], p1, 0, 0, 0); }
#elif ATT_QKPIPE == 1
    bf16x8 a0 = KRD(0, 0), a1 = KRD(0, 1);
#pragma unroll
    for (int s = 0; s < 12; ++s) {
        bf16x8 n0 = a0, n1 = a1;
        if (s + 1 < 12) { n0 = KRD(s + 1, 0); n1 = KRD(s + 1, 1); }
        SB_ALU();
        p0 = __builtin_amdgcn_mfma_f32_32x32x16_bf16(a0, qr[s], p0, 0, 0, 0); p1 = __builtin_amdgcn_mfma_f32_32x32x16_bf16(a1, qr[s], p1, 0, 0, 0);
        SB_ALU();
        a0 = n0; a1 = n1;
    }
#else
    bf16x8 a0 = KRD(0, 0), a1 = KRD(0, 1), b0 = KRD(1, 0), b1 = KRD(1, 1);
#pragma unroll
    for (int s = 0; s < 12; ++s) {
        bf16x8 n0 = a0, n1 = a1;
        if (s + 2 < 12) { n0 = KRD(s + 2, 0); n1 = KRD(s + 2, 1); }
        SB_ALU();
        p0 = __builtin_amdgcn_mfma_f32_32x32x16_bf16(a0, qr[s], p0, 0, 0, 0); p1 = __builtin_amdgcn_mfma_f32_32x32x16_bf16(a1, qr[s], p1, 0, 0, 0);
        SB_ALU();
        a0 = b0; a1 = b1; b0 = n0; b1 = n1;
    }
#endif
#undef KRD
}
__device__ __forceinline__ int v_st(int k, int c) { const int kk = (k & ~0xC) | ((k & 4) << 1) | ((k & 8) >> 1); return ((kk >> 3) * 4 + (c >> 5)) * 512 + ((kk & 7) * 32 + (c & 31)) * 2; }
__device__ __forceinline__ int v_rd_base(int lane) { return ((lane & 3) << 3) | (((lane >> 2) & 3) << 6) | (((lane >> 4) & 1) << 5) | (((lane >> 5) & 1) << 8); }
constexpr int v_rd_off(int d0, int ks, int half) { return d0 * 512 + ks * 4096 + half * 2048; }
template <int OFF> __device__ __forceinline__ s16x4 tr_read(int vb) {
    s16x4 r; asm volatile("ds_read_b64_tr_b16 %0, %1 offset:%2" : "=&v"(r) : "v"(vb), "i"(OFF) : "memory"); return r;
}
template <int D0> __device__ __forceinline__ void pv_one(f32x16& od, int vb, bf16x8 pa0, bf16x8 pa1, bf16x8 pa2, bf16x8 pa3) {
    const s16x4 l0 = tr_read<v_rd_off(D0, 0, 0)>(vb), h0 = tr_read<v_rd_off(D0, 0, 1)>(vb), l1 = tr_read<v_rd_off(D0, 1, 0)>(vb), h1 = tr_read<v_rd_off(D0, 1, 1)>(vb);
    const s16x4 l2 = tr_read<v_rd_off(D0, 2, 0)>(vb), h2 = tr_read<v_rd_off(D0, 2, 1)>(vb), l3 = tr_read<v_rd_off(D0, 3, 0)>(vb), h3 = tr_read<v_rd_off(D0, 3, 1)>(vb);
    asm volatile("s_waitcnt lgkmcnt(0)" ::: "memory"); SBAR();
#define PK(L, H) (bf16x8){L[0], L[1], L[2], L[3], H[0], H[1], H[2], H[3]}
    od = __builtin_amdgcn_mfma_f32_32x32x16_bf16(pa0, PK(l0, h0), od, 0, 0, 0);
    od = __builtin_amdgcn_mfma_f32_32x32x16_bf16(pa1, PK(l1, h1), od, 0, 0, 0);
    od = __builtin_amdgcn_mfma_f32_32x32x16_bf16(pa2, PK(l2, h2), od, 0, 0, 0);
    od = __builtin_amdgcn_mfma_f32_32x32x16_bf16(pa3, PK(l3, h3), od, 0, 0, 0);
#undef PK
}
__device__ __forceinline__ void pv_d0(f32x16 (&o)[4], int vb, bf16x8 pa0, bf16x8 pa1, bf16x8 pa2, bf16x8 pa3) {
    pv_one<0>(o[0], vb, pa0, pa1, pa2, pa3); pv_one<1>(o[1], vb, pa0, pa1, pa2, pa3); pv_one<2>(o[2], vb, pa0, pa1, pa2, pa3); pv_one<3>(o[3], vb, pa0, pa1, pa2, pa3);
}
#ifndef ATT_FUSE
#define ATT_FUSE 1
#endif
#define SB0() __builtin_amdgcn_sched_barrier(0)
#define MF32(acc, a, b) acc = __builtin_amdgcn_mfma_f32_32x32x16_bf16(a, b, acc, 0, 0, 0)
#define PK4F(P, BASE, OUT) do { unsigned a0_ = cvt_pk_bf16(P[BASE + 0], P[BASE + 1]), a1_ = cvt_pk_bf16(P[BASE + 2], P[BASE + 3]);   \
    unsigned b0_ = cvt_pk_bf16(P[BASE + 4], P[BASE + 5]), b1_ = cvt_pk_bf16(P[BASE + 6], P[BASE + 7]);                              \
    auto r0_ = __builtin_amdgcn_permlane32_swap(a0_, b0_, false, false); auto r1_ = __builtin_amdgcn_permlane32_swap(a1_, b1_, false, false); \
    u32x4 w_ = {r0_[0], r1_[0], r0_[1], r1_[1]}; OUT = *reinterpret_cast<bf16x8*>(&w_); } while (0)
__device__ __forceinline__ void qk_fin(f32x16& n0, f32x16& n1, const LAS unsigned char* Kn, const LAS unsigned char* Kr, const bf16x8 (&qr)[12], int r32, int hi,
                                       f32x16& o0, f32x16& o1, float alpha, float& l_reg, bf16x8& pa0, bf16x8& pa1, bf16x8& pa2, bf16x8& pa3) {
    n0 = f32x16{}; n1 = f32x16{};
#define KRD(s, half) ((s) < 8 ? *(const LAS bf16x8*)(Kn + KNSWZ(32 * (half) + r32, ((s) * 16 + hi * 8) * 2)) : *(const LAS bf16x8*)(Kr + KRSWZ(32 * (half) + r32, (((s) - 8) * 16 + hi * 8) * 2)))
    float ps0 = 0.f, ps1 = 0.f;
#define FIN_SLOT(t) do { if ((t) < 16) { o1[(t) & 15] = __builtin_amdgcn_exp2f(o1[(t) & 15]); ps0 += o0[(t) & 15]; if ((t) > 0) ps1 += o1[((t) - 1) & 15]; } \
        else if ((t) == 16) { ps1 += o1[15]; PK4F(o0, 0, pa0); } else if ((t) == 17) { PK4F(o0, 8, pa1); } else if ((t) == 18) { PK4F(o1, 0, pa2); } else if ((t) == 19) { PK4F(o1, 8, pa3); } \
        else if ((t) == 20) { float ps_ = ps0 + ps1; auto rr_ = __builtin_amdgcn_permlane32_swap(__float_as_uint(ps_), __float_as_uint(ps_), false, false); \
            ps_ = __uint_as_float(rr_[0]) + __uint_as_float(rr_[1]); l_reg = l_reg * alpha + ps_; } } while (0)
#define SB_DS() __builtin_amdgcn_sched_barrier(0x0100)
    bf16x8 a0 = KRD(0, 0);
#pragma unroll
    for (int s = 0; s < 12; ++s) {
        const bf16x8 a1 = KRD(s, 1);
        bf16x8 x0 = a0; if (s + 1 < 12) x0 = KRD(s + 1, 0);
        SB0();
        MF32(n0, a0, qr[s]); FIN_SLOT(2 * s); SB0();
        MF32(n1, a1, qr[s]); FIN_SLOT(2 * s + 1); SB0();
        a0 = x0;
    }
#undef SB_DS
#undef FIN_SLOT
#undef KRD
}
template <int OFF> __device__ __forceinline__ void tr_rd(s16x4& r, int vb) { asm volatile("ds_read_b64_tr_b16 %0, %1 offset:%2" : "=&v"(r) : "v"(vb), "i"(OFF) : "memory"); }
__device__ __forceinline__ void pv_part(f32x16 (&o)[4], int vb, bf16x8 pa0, bf16x8 pa1, bf16x8 pa2, bf16x8 pa3, f32x16& p0, f32x16& p1, float& m_reg, float& mn, float& alpha) {
    constexpr float C = SCALE * 1.4426950408889634f;
    s16x4 va[8], vn[8];
#define PKV(L, H) (bf16x8){L[0], L[1], L[2], L[3], H[0], H[1], H[2], H[3]}
#define RDV(dst, D0, i) do { if ((i) == 0) { tr_rd<v_rd_off(D0, 0, 0)>(dst[0], vb); tr_rd<v_rd_off(D0, 0, 1)>(dst[1], vb); } else if ((i) == 1) { tr_rd<v_rd_off(D0, 1, 0)>(dst[2], vb); tr_rd<v_rd_off(D0, 1, 1)>(dst[3], vb); } \
        else if ((i) == 2) { tr_rd<v_rd_off(D0, 2, 0)>(dst[4], vb); tr_rd<v_rd_off(D0, 2, 1)>(dst[5], vb); } else { tr_rd<v_rd_off(D0, 3, 0)>(dst[6], vb); tr_rd<v_rd_off(D0, 3, 1)>(dst[7], vb); } } while (0)
    RDV(va, 0, 0); RDV(va, 0, 1); RDV(va, 0, 2); RDV(va, 0, 3);
    float pmax = p0[0], mnC = 0.f;
#define SM_SLOT(u) do { \
        if ((u) == 0) { _Pragma("unroll") for (int r = 1; r < 9; ++r) pmax = fmaxf(pmax, p0[r]); } \
        else if ((u) == 1) { _Pragma("unroll") for (int r = 9; r < 16; ++r) pmax = fmaxf(pmax, p0[r]); pmax = fmaxf(pmax, p1[0]); } \
        else if ((u) == 2) { _Pragma("unroll") for (int r = 1; r < 9; ++r) pmax = fmaxf(pmax, p1[r]); } \
        else if ((u) == 3) { _Pragma("unroll") for (int r = 9; r < 16; ++r) pmax = fmaxf(pmax, p1[r]); \
            auto rr_ = __builtin_amdgcn_permlane32_swap(__float_as_uint(pmax), __float_as_uint(pmax), false, false); pmax = fmaxf(__uint_as_float(rr_[0]), __uint_as_float(rr_[1])); } \
        else if ((u) == 4) { if (__builtin_expect(__all(pmax - m_reg <= THR / SCALE), 1)) { mn = m_reg; alpha = 1.f; } \
            else { mn = fmaxf(m_reg, pmax); alpha = __builtin_amdgcn_exp2f((m_reg - mn) * C); m_reg = mn; } mnC = -mn * C; } \
        else { constexpr int i_ = (u) - 5; _Pragma("unroll") for (int v = 3 * i_; v < 3 * i_ + 3; ++v) { if (v < 16) p0[v & 15] = fmaf(p0[v & 15], C, mnC); else if (v < 32) p1[(v - 16) & 15] = fmaf(p1[(v - 16) & 15], C, mnC); } \
            _Pragma("unroll") for (int e = (16 * i_ + 10) / 11; e < (16 * (i_ + 1) + 10) / 11; ++e) { if (e < 16) p0[e & 15] = __builtin_amdgcn_exp2f(p0[e & 15]); } } } while (0)
#define PV_BLOCK(D0, CUR, NXT) do { asm volatile("s_waitcnt lgkmcnt(0)" ::: "memory"); SB0(); \
        MF32(o[D0], pa0, PKV(CUR[0], CUR[1])); if ((D0) < 3) RDV(NXT, (D0) + 1, 0); SM_SLOT(4 * (D0) + 0); SB0(); \
        MF32(o[D0], pa1, PKV(CUR[2], CUR[3])); if ((D0) < 3) RDV(NXT, (D0) + 1, 1); SM_SLOT(4 * (D0) + 1); SB0(); \
        MF32(o[D0], pa2, PKV(CUR[4], CUR[5])); if ((D0) < 3) RDV(NXT, (D0) + 1, 2); SM_SLOT(4 * (D0) + 2); SB0(); \
        MF32(o[D0], pa3, PKV(CUR[6], CUR[7])); if ((D0) < 3) RDV(NXT, (D0) + 1, 3); SM_SLOT(4 * (D0) + 3); SB0(); } while (0)
    PV_BLOCK(0, va, vn); PV_BLOCK(1, vn, va); PV_BLOCK(2, va, vn); PV_BLOCK(3, vn, va);
    asm volatile("" : "+v"(p0), "+v"(p1));
#undef PV_BLOCK
#undef SM_SLOT
#undef RDV
#undef PKV
}
constexpr int BUF = SHM_V + SHM_KN + SHM_KR;
constexpr int OFF_WS3 = 3 * BUF;
__device__ __forceinline__ void attn_unit(const bf16_t* __restrict__ Q, const bf16_t* __restrict__ KV, const bf16_t* __restrict__ KRp, const float* __restrict__ ropec, const float* __restrict__ ropes,
                                          bf16_t* __restrict__ O, int h, int q0, LAS unsigned char* lds) {
    const int tid = otid(), wid = __builtin_amdgcn_readfirstlane(tid >> 6), lane = tid & 63, r32 = lane & 31, hi = lane >> 5;
    LAS float* wsx = (LAS float*)(lds + OFF_WS3) + wid * 64; LAS float* li_l = wsx; LAS float* al_l = wsx + 32;
    const bf16_t* Kh = KV + h * 256; const bf16_t* Vh = KV + h * 256 + 128;
    unsigned gV, gK, gR;
    { const int p = wid * 64 + lane;
        { const int st = p >> 5, kk = 8 * (st >> 2) + ((p & 31) >> 2), k = (kk & ~0xC) | ((kk & 4) << 1) | ((kk & 8) >> 1), c = 32 * (st & 3) + 8 * (p & 3); gV = (unsigned)(k * NKV + c); }
        { const int row = p >> 4, lc = (p & 15) ^ (row & 15); gK = (unsigned)(row * NKV + lc * 8); } }
    { const int p = wid * 64 + lane, row = p >> 3, lc = (p & 7) ^ ((row >> 1) & 7); gR = (unsigned)(row * N_INP + lc * 8); }
#define DMA16(src, dstoff) __builtin_amdgcn_global_load_lds((const unsigned*)(src), (LAS unsigned*)(lds + (dstoff)), 16, 0, 0)
#define ISSUE(tile, boff) do { const bf16_t* _v = Vh + (size_t)(tile) * KVBLK * NKV; const bf16_t* _k = Kh + (size_t)(tile) * KVBLK * NKV; const bf16_t* _r = KRp + (size_t)(tile) * KVBLK * N_INP; \
        DMA16(_v + gV, (boff) + wid * 1024); DMA16(_v + 32 * NKV + gV, (boff) + 8192 + wid * 1024); \
        DMA16(_k + gK, (boff) + SHM_V + wid * 1024); DMA16(_k + 32 * NKV + gK, (boff) + SHM_V + 8192 + wid * 1024); \
        DMA16(_r + gR, (boff) + SHM_V + SHM_KN + wid * 1024); } while (0)
    ISSUE(0, 0); ISSUE(1, BUF);
    float m_reg = -1e30f, l_reg = 0; f32x16 o[4] = {}; bf16x8 qr[12];
    {   const int qrow = q0 + wid * QBLK + r32;
        const bf16_t* Qw = Q + (size_t)qrow * NQ + h * DQK + hi * 8;
#pragma unroll
        for (int d0 = 0; d0 < 12; ++d0) qr[d0] = *(const bf16x8*)(Qw + d0 * 16);
#pragma unroll
        for (int e = 0; e < 2; ++e) { const float* cp = ropec + (size_t)qrow * 32 + e * 16 + hi * 8; const float* sp = ropes + (size_t)qrow * 32 + e * 16 + hi * 8;
            const f32x4 c0 = *(const f32x4*)cp, c1 = *(const f32x4*)(cp + 4), s0 = *(const f32x4*)sp, s1 = *(const f32x4*)(sp + 4);
            bf16x8 a = qr[8 + e], b = qr[10 + e]; unsigned na[4], nb[4];
#pragma unroll
            for (int j = 0; j < 4; ++j) {
                const float t1a = bf2f((unsigned short)a[2 * j]), t1b = bf2f((unsigned short)a[2 * j + 1]), t2a = bf2f((unsigned short)b[2 * j]), t2b = bf2f((unsigned short)b[2 * j + 1]);
                const float ca = (2 * j < 4) ? c0[(2 * j) & 3] : c1[(2 * j) & 3], cb = (2 * j + 1 < 4) ? c0[(2 * j + 1) & 3] : c1[(2 * j + 1) & 3];
                const float sa = (2 * j < 4) ? s0[(2 * j) & 3] : s1[(2 * j) & 3], sb = (2 * j + 1 < 4) ? s0[(2 * j + 1) & 3] : s1[(2 * j + 1) & 3];
                na[j] = cvt_pk_bf16(t1a * ca - t2a * sa, t1b * cb - t2b * sb); nb[j] = cvt_pk_bf16(t2a * ca + t1a * sa, t2b * cb + t1b * sb); }
            u32x4 wa = {na[0], na[1], na[2], na[3]}, wb = {nb[0], nb[1], nb[2], nb[3]};
            qr[8 + e] = *reinterpret_cast<bf16x8*>(&wa); qr[10 + e] = *reinterpret_cast<bf16x8*>(&wb); }
    }
    const int vbase = (int)(unsigned)(uintptr_t)lds + v_rd_base(lane);
#define RESC(a) do { if (__any((a) < 1.f)) { if (hi == 0) al_l[r32] = (a); asm volatile("s_waitcnt lgkmcnt(0)" ::: "memory"); \
    _Pragma("unroll") for (int d = 0; d < 4; ++d) _Pragma("unroll") for (int r = 0; r < 16; ++r) o[d][r] *= al_l[crow(r, hi)]; } } while (0)
#define TILE_SYNC() do { asm volatile("s_waitcnt vmcnt(0) lgkmcnt(0)" ::: "memory"); __builtin_amdgcn_s_barrier(); asm volatile("" ::: "memory"); } while (0)
    f32x16 pA0, pA1, pB0, pB1; float mnA, mnB, alA, alB; bf16x8 pa0, pa1, pa2, pa3; constexpr int NT = SEQ / KVBLK;
    TILE_SYNC();
    qkt(pA0, pA1, lds + SHM_V, lds + SHM_V + SHM_KN, qr, r32, hi); partialSM(pA0, pA1, m_reg, mnA, alA);
    ISSUE(2, 2 * BUF);
    int bc = BUF, bp = 0, bn = 2 * BUF;
    for (int j = 1; j + 1 < NT; j += 2) {
#if ATT_FUSE
        SBAR(); qk_fin(pB0, pB1, lds + bc + SHM_V, lds + bc + SHM_V + SHM_KN, qr, r32, hi, pA0, pA1, alA, l_reg, pa0, pa1, pa2, pa3);
        pv_part(o, vbase + bp, pa0, pa1, pa2, pa3, pB0, pB1, m_reg, mnB, alB);
#else
        SBAR(); qkt(pB0, pB1, lds + bc + SHM_V, lds + bc + SHM_V + SHM_KN, qr, r32, hi);
        finishSM(pA0, pA1, alA, l_reg, pa0, pa1, pa2, pa3); QK_ILV(); SBAR();
        pv_d0(o, vbase + bp, pa0, pa1, pa2, pa3); partialSM(pB0, pB1, m_reg, mnB, alB);
#endif
        TILE_SYNC();
        ISSUE(j + 2, bp);
        RESC(alB);
        { const int t = bp; bp = bc; bc = bn; bn = t; }
#if ATT_FUSE
        SBAR(); qk_fin(pA0, pA1, lds + bc + SHM_V, lds + bc + SHM_V + SHM_KN, qr, r32, hi, pB0, pB1, alB, l_reg, pa0, pa1, pa2, pa3);
        pv_part(o, vbase + bp, pa0, pa1, pa2, pa3, pA0, pA1, m_reg, mnA, alA);
#else
        SBAR(); qkt(pA0, pA1, lds + bc + SHM_V, lds + bc + SHM_V + SHM_KN, qr, r32, hi);
        finishSM(pB0, pB1, alB, l_reg, pa0, pa1, pa2, pa3); QK_ILV(); SBAR();
        pv_d0(o, vbase + bp, pa0, pa1, pa2, pa3); partialSM(pA0, pA1, m_reg, mnA, alA);
#endif
        TILE_SYNC();
        if (j + 3 < NT) ISSUE(j + 3, bp);
        RESC(alA);
        { const int t = bp; bp = bc; bc = bn; bn = t; }
    }
    SBAR(); qkt(pB0, pB1, lds + bc + SHM_V, lds + bc + SHM_V + SHM_KN, qr, r32, hi);
    finishSM(pA0, pA1, alA, l_reg, pa0, pa1, pa2, pa3); SBAR();
    pv_d0(o, vbase + bp, pa0, pa1, pa2, pa3); partialSM(pB0, pB1, m_reg, mnB, alB);
    RESC(alB);
    finishSM(pB0, pB1, alB, l_reg, pa0, pa1, pa2, pa3); SBAR();
    pv_d0(o, vbase + bc, pa0, pa1, pa2, pa3);
    if (hi == 0) li_l[r32] = l_reg; asm volatile("s_waitcnt lgkmcnt(0)" ::: "memory");
    float rli[16];
#pragma unroll
    for (int r = 0; r < 16; ++r) rli[r] = __builtin_amdgcn_rcpf(li_l[crow(r, hi)]);
    bf16_t* Ow = O + (size_t)(q0 + wid * QBLK) * MEM_W + h * V_DIM;
#pragma unroll
    for (int r = 0; r < 16; ++r) { const int orow = crow(r, hi);
#pragma unroll
        for (int d0 = 0; d0 < 4; ++d0) Ow[(size_t)orow * MEM_W + d0 * 32 + r32] = f2bf(o[d0][r] * rli[r]); }
#undef DMA16
#undef ISSUE
#undef RESC
#undef TILE_SYNC
}
}
constexpr int PH_PER_LAYER = 18, N_PHASES = 2 + DEPTH * PH_PER_LAYER;
#if MK_CHECK
#include "checks.h"
#else
#define CHECK_PHASE(k) do { } while (0)
#endif

#define CAS __attribute__((address_space(4)))
#define KARGS() ((const CAS Args*)optr((const CAS unsigned char*)__builtin_amdgcn_kernarg_segment_ptr()))
__global__ void __launch_bounds__(512, 2) enc_fwd(Args args) {
    extern __shared__ __attribute__((aligned(16))) unsigned char lds_raw[];
    struct { LAS unsigned char* lds; } F0; F0.lds = (LAS unsigned char*)lds_raw;
#define F F0
    volatile LAS unsigned* MISC = (volatile LAS unsigned*)(F.lds + MISC_OFF);
    unsigned* ctl = (unsigned*)(KARGS()->ws + WS_CTL);
    if (threadIdx.x < 64) MISC[threadIdx.x] = 0u;
    __syncthreads();
    if (KARGS()->ph_hi - KARGS()->ph_lo > 1) (void)xcd_barrier_post(ctl + CW_BAR, MISC + 8);
#define lo (KARGS()->ph_lo)
#define hi (KARGS()->ph_hi)
#ifndef ONLY
#define ONLY -1
#endif
#define RELPH(k) ((k) < 2 ? 100 + (k) : ((k) - 2) % PH_PER_LAYER)
#define IN(k) (lo <= (k) && (k) < hi && (ONLY < 0 || RELPH(k) == ONLY))
#ifndef REPMASK
#define REPMASK 0u
#endif
#define NREP(k) (1 + (int)((REPMASK >> (RELPH(k) >= 100 ? RELPH(k) - 70 : RELPH(k))) & 1u))
#ifndef SPLIT_UP
#define SPLIT_UP 0
#endif
#ifndef GATE_DEAL
#define GATE_DEAL 1
#endif
#ifndef UP_SPLIT
#define UP_SPLIT 1
#endif
#ifndef DOUBLE_BAR
#define DOUBLE_BAR 0
#endif
#define LSEAM(k) do { CHECK_PHASE(k); if (IN((k) + 1)) { VM_WAIT(); __syncthreads(); if (threadIdx.x == 0) { __builtin_amdgcn_fence(__ATOMIC_ACQUIRE, "agent"); VM_WAIT(); } __syncthreads(); } } while (0)
#define SEAM(k) do { CHECK_PHASE(k); if (IN((k) + 1)) { XcdBarrier bar_; bar_.bar = (unsigned*)(KARGS()->ws + WS_CTL) + CW_BAR; bar_.x = xb_xcc_id(); bar_.st = (volatile LAS unsigned*)(ring + MISC_OFF) + 8; xcd_barrier(bar_); if (DOUBLE_BAR) xcd_barrier(bar_); } } while (0)
    LAS unsigned char* const ring = F.lds;
#undef F
    const int G = gridDim.x, bid = blockIdx.x;
#define PTRS() const CAS Args* const ap = KARGS(); unsigned char* const ws = ap->ws; const Frame F = make_frame(ring); (void)F; \
    bf16_t* const H = (bf16_t*)(ws + WS_H); bf16_t* const Z = (bf16_t*)(ws + WS_Z); bf16_t* const GATES = (bf16_t*)(ws + WS_GATES); \
    bf16_t* const WT1 = (bf16_t*)(ws + WS_WT1); bf16_t* const S1O = (bf16_t*)(ws + WS_S1O); bf16_t* const YF = (bf16_t*)(ws + WS_YF); \
    bf16_t* const Qb = (bf16_t*)(ws + WS_Q); bf16_t* const KVb = (bf16_t*)(ws + WS_KV); bf16_t* const OA = (bf16_t*)(ws + WS_OA); bf16_t* const SGO = (bf16_t*)(ws + WS_SGO); \
    bf16_t* const MERGED = (bf16_t*)(ws + WS_MERGED); bf16_t* const Y = (bf16_t*)(ws + WS_Y); \
    bf16_t* const QM = (bf16_t*)(ws + WS_QM); bf16_t* const PM = (bf16_t*)(ws + WS_PM); bf16_t* const OM = (bf16_t*)(ws + WS_OM); \
    bf16_t* const U = (bf16_t*)(ws + WS_U); bf16_t* const ACTB = (bf16_t*)(ws + WS_ACTV); \
    float* const RS = (float*)(ws + WS_RSTD); (void)RS; float* const RSQ = (float*)(ws + WS_RSQ); (void)RSQ; \
    const float* const ropec = (const float*)(ws + WS_ROPEC); const float* const ropes = (const float*)(ws + WS_ROPES); \
    const unsigned char* const wl = ws + WS_W + (size_t)l * W_LAYER; \
    float* const X = ap->out; (void)X; \
    (void)H; (void)Z; (void)GATES; (void)WT1; (void)S1O; (void)YF; (void)Qb; (void)KVb; (void)OA; (void)SGO; (void)MERGED; (void)Y; (void)QM; (void)PM; (void)OM; (void)U; (void)ACTB; (void)ropec; (void)ropes; (void)wl

    if (IN(0)) { _Pragma("unroll 1") for (int rep_ = 0; rep_ < NREP(0); ++rep_) { const Frame F = make_frame(ring); prologue_phase(F, KARGS()); } SEAM(0); }
#pragma unroll 1
    for (int l = 0; l < DEPTH; ++l) {
        const int pb = 2 + PH_PER_LAYER * l;
        if (IN(pb + 0)) { _Pragma("unroll 1") for (int rep_ = 0; rep_ < NREP(pb + 0); ++rep_) { PTRS();
#ifndef TEST_NO_MEMKV
            if (l == 0) {
#pragma unroll 1
                for (int k = 0; k < 4; ++k) { const int lm = k >> 1; const bf16_t* memn = (const bf16_t*)(ws + WS_MEMN) + (size_t)lm * MEM_T * DM; const unsigned char* wm = ws + WS_W + (size_t)lm * W_LAYER;
                    pg8::StaticOrder S; const int c = (bid + 2 * G - G / 2 - 4 * k) % G;
                    pg8::Gemm g = (k & 1) == 0 ? pg8::make_gemm(memn, DM, (const bf16_t*)(wm + WO_MK), DM, MEM_T, MEM_W, DM) : pg8::make_gemm((const bf16_t*)(wm + WO_MV), DM, memn, DM, MEM_W, MEM_T, DM);
                    S.init(g.nM, g.nN, G, c);
                    pg8::EpiStore E{(k & 1) == 0 ? (bf16_t*)(ws + WS_KMEM) + (size_t)lm * MEM_T * MEM_W : (bf16_t*)(ws + WS_VMEMT) + (size_t)lm * MEM_W * MEM_T, (k & 1) == 0 ? MEM_W : MEM_T, (k & 1) == 0 ? (size_t)0 : (size_t)256 * MEM_T, (k & 1) == 0 ? (size_t)256 : (size_t)0, nullptr};
                    pg8::gemm_phase(ring, g, S, E); }
            }
#endif
            {
              pg8::Gemm g = pg8::make_gemm(H, DM, (const bf16_t*)(wl + WO_ING), DM, SEQ, N_ZB, DM); pg8::StaticOrder S; S.init(g.nM, g.nN, G, bid);
              pg8::EpiZB E{Z, RS}; pg8::gemm_phase(ring, g, S, E); }
            {
              pg8::Gemm g; g.A = ws + WS_XB8; g.B = wl + WO_ING + WOI_Q8; g.tsA = (size_t)256 * DM; g.pnA = 0; g.tsB = (size_t)256 * DM; g.pmB = 0; g.rsA = DM; g.rsB = DM;
              g.hsA = (size_t)128 * DM; g.hsB = (size_t)128 * DM; g.nM = SEQ / 256; g.nN = N_Q8 / 256; g.nt = DM / 128; pg8::GateOrder S; S.init(g.nM, g.nN, G, bid);
              S.mode = (G == 256 && GATE_DEAL) ? ((l == 0) ? 2 : 1) : 0; S.r0 = F_INT8 ? 16 : 15;
              pg8::EpiInQ E{Z, GATES, ap->in[17] + (size_t)l * N_GATE, RSQ, (const float*)(ws + WS_CS + (size_t)l * CS_LAYER)}; pg8::gemm_phase<pg8::EpiInQ, 2, pg8::GateOrder>(ring, g, S, E); }
            } SEAM(pb + 0); }
        if (IN(pb + 1)) { _Pragma("unroll 1") for (int rep_ = 0; rep_ < NREP(pb + 1); ++rep_) { PTRS();
            if (rep_ == 0) prep_rows(F, Z, ap->in[6] + (size_t)l * Q_LORA, ap->in[8] + (size_t)l * KV_LORA, ropec, ropes);
#pragma unroll 1
            for (int ri = 0; ri < 2; ++ri) { pg8::Gemm g; g.A = ws + (ri ? WS_DIM : WS_DRE); g.B = Z + ZC_F; g.tsA = 0; g.pnA = 0; g.tsB = (size_t)2 * N_INP * 2; g.pmB = 512; g.rsA = 512u; g.rsB = 128u * N_INP * 2u;
                g.hsA = 65536; g.hsB = (size_t)N_INP * 2; g.nM = 4; g.nN = 64; g.nt = 4; pg8::StaticOrder S; S.init(4, 64, G, bid);
                pg8::EpiCD E{WT1, ri}; pg8::gemm_phase(ring, g, S, E); }
            sg_phase(F, Z, (const bf16_t*)(ws + WS_SGW) + (size_t)l * 16 * 128 * 128, ap->in[10] + (size_t)l * SG_WIDTH, ap->in[12] + (size_t)l * 16 * 128, SGO);
            } SEAM(pb + 1);
        }
        if (IN(pb + 2)) { _Pragma("unroll 1") for (int rep_ = 0; rep_ < NREP(pb + 2); ++rep_) { PTRS();
            { pg8::Gemm g = pg8::make_gemm(Z + ZC_CQ, N_INP, (const bf16_t*)(wl + WO_UQ), Q_LORA, SEQ, NQ, Q_LORA); pg8::StaticOrder S; S.init(g.nM, g.nN, G, bid);
              pg8::EpiStore E{Qb, NQ, (size_t)256 * NQ, 256, nullptr}; pg8::gemm_phase(ring, g, S, E); }
            { pg8::Gemm g = pg8::make_gemm(Z + ZC_CKV, N_INP, (const bf16_t*)(wl + WO_UKV), KV_LORA, SEQ, NKV, KV_LORA); pg8::StaticOrder S; S.init(g.nM, g.nN, G, bid);
              pg8::EpiStore E{KVb, NKV, (size_t)256 * NKV, 256, nullptr}; pg8::gemm_phase(ring, g, S, E); }
            { pg8::Gemm g; g.A = ws + WS_F1; g.B = WT1; g.tsA = 0; g.pnA = 0; g.tsB = 131072; g.pmB = 0; g.rsA = 512u; g.rsB = 512u; g.hsA = 65536; g.hsB = 65536; g.nM = 1; g.nN = 512; g.nt = 4;
              pg8::StaticOrder S; S.init(1, 512, G, bid); pg8::EpiS1 E{S1O, (const float*)(ws + WS_TWC), (const float*)(ws + WS_TWS)}; pg8::gemm_phase(ring, g, S, E); }
            } SEAM(pb + 2);
        }
        if (IN(pb + 3)) { _Pragma("unroll 1") for (int rep_ = 0; rep_ < NREP(pb + 3); ++rep_) { PTRS();
            { pg8::Gemm g; g.A = ws + WS_F3; g.B = S1O; g.tsA = 0; g.pnA = 0; g.tsB = 131072; g.pmB = 0; g.rsA = 512u; g.rsB = 512u; g.hsA = 65536; g.hsB = 65536; g.nM = 1; g.nN = 512; g.nt = 4;
              pg8::StaticOrder S; S.init(1, 512, G, bid); pg8::EpiS3 E{YF}; pg8::gemm_phase(ring, g, S, E); }
            if ((G & 7) == 0 && (SEQ / 256) % (G / 8) == 0) {
                const int per = G / 8; for (int qb = bid >> 3; qb < SEQ / 256; qb += per) { __syncthreads(); att::attn_unit(Qb, KVb, Z + ZC_KR, ropec, ropes, OA, bid & 7, qb * 256, ring); } }
            else for (int u = bid; u < MLA_H * (SEQ / 256); u += G) { __syncthreads(); att::attn_unit(Qb, KVb, Z + ZC_KR, ropec, ropes, OA, u >> 6, (u & 63) * 256, ring); }
            __syncthreads(); } SEAM(pb + 3);
        }
        if (IN(pb + 6)) { _Pragma("unroll 1") for (int rep_ = 0; rep_ < NREP(pb + 6); ++rep_) { PTRS();
#pragma unroll 1
            for (int b = 0; b < 3; ++b) {
                const bf16_t* A = b == 0 ? YF : (b == 1 ? OA : SGO); const int K = b == 2 ? SG_WIDTH : 1024; const bf16_t* W = (const bf16_t*)(wl + (b == 0 ? WO_BRF : (b == 1 ? WO_BRA : WO_BRS)));
                if (b > 0) { VM_WAIT(); __syncthreads(); if (F.tid == 0) { __builtin_amdgcn_fence(__ATOMIC_ACQUIRE, "agent"); VM_WAIT(); } __syncthreads(); }
                pg8::Gemm g = pg8::make_gemm(A, K, W, K, SEQ, DM, K); pg8::StaticOrder S; S.init(g.nM, g.nN, G, bid);
                pg8::EpiMerge E{MERGED, GATES + (size_t)b * DM, b == 0 ? 1 : 0}; pg8::gemm_phase(ring, g, S, E); }
            } SEAM(pb + 6);
        }
        if (IN(pb + 7)) { _Pragma("unroll 1") for (int rep_ = 0; rep_ < NREP(pb + 7); ++rep_) { PTRS(); pg8::Gemm g = pg8::make_gemm(MERGED, DM, (const bf16_t*)(wl + WO_OUT), DM, SEQ, DM, DM); pg8::StaticOrder S; S.init(g.nM, g.nN, G, bid);
            pg8::EpiStore E{Y, DM, (size_t)256 * DM, 256, nullptr}; pg8::gemm_phase(ring, g, S, E); } SEAM(pb + 7); }
        if (IN(pb + 8)) { _Pragma("unroll 1") for (int rep_ = 0; rep_ < NREP(pb + 8); ++rep_) { PTRS(); resnorm_rows(F, Y, ap->in[4] + (size_t)l * DM, H, (rep_ + 1 < NREP(pb + 8)) ? MERGED : H, (rep_ + 1 < NREP(pb + 8)) ? RS + SEQ : RS, nullptr, nullptr, nullptr); } SEAM(pb + 8); }
        if (IN(pb + 9)) { _Pragma("unroll 1") for (int rep_ = 0; rep_ < NREP(pb + 9); ++rep_) { PTRS(); pg8::Gemm g = pg8::make_gemm(H, DM, (const bf16_t*)(wl + WO_MQ), DM, SEQ, MEM_W, DM); pg8::StaticOrder S; S.init(g.nM, g.nN, G, bid);
            pg8::EpiStore E{QM, MEM_W, (size_t)256 * MEM_W, 256, RS}; pg8::gemm_phase(ring, g, S, E); } LSEAM(pb + 9); }
        if (IN(pb + 10)) { _Pragma("unroll 1") for (int rep_ = 0; rep_ < NREP(pb + 10); ++rep_) { PTRS(); pg8::Gemm g; g.A = QM; g.B = (const bf16_t*)(ws + WS_KMEM) + (size_t)l * MEM_T * MEM_W; g.tsA = (size_t)256 * MEM_W * 2; g.pnA = 512; g.tsB = 512; g.pmB = 0; g.rsA = 2048u; g.rsB = 2048u;
            g.hsA = (size_t)128 * 2048; g.hsB = (size_t)128 * 2048; g.nM = 64; g.nN = 4; g.nt = 4; pg8::StaticOrder S; S.init(64, 4, G, bid);
            pg8::EpiSoftmax E{PM, (LAS float*)(F.lds + EPX_OFF)}; pg8::gemm_phase(ring, g, S, E); } LSEAM(pb + 10); }
        if (IN(pb + 11)) { _Pragma("unroll 1") for (int rep_ = 0; rep_ < NREP(pb + 11); ++rep_) { PTRS(); pg8::Gemm g; g.A = PM; g.B = (const bf16_t*)(ws + WS_VMEMT) + (size_t)l * MEM_W * MEM_T; g.tsA = (size_t)256 * MEM_W * 2; g.pnA = 512; g.tsB = 131072; g.pmB = 0; g.rsA = 2048u; g.rsB = 512u;
            g.hsA = (size_t)128 * 2048; g.hsB = 65536; g.nM = 64; g.nN = 4; g.nt = 4; pg8::StaticOrder S; S.init(64, 4, G, bid);
            pg8::EpiStore E{OM, MEM_W, (size_t)256 * MEM_W, 256, nullptr}; pg8::gemm_phase(ring, g, S, E); } SEAM(pb + 11); }
        if (IN(pb + 12)) { _Pragma("unroll 1") for (int rep_ = 0; rep_ < NREP(pb + 12); ++rep_) { PTRS(); pg8::Gemm g = pg8::make_gemm(OM, MEM_W, (const bf16_t*)(wl + WO_MO), MEM_W, SEQ, DM, MEM_W); pg8::StaticOrder S; S.init(g.nM, g.nN, G, bid);
            pg8::EpiStore E{Y, DM, (size_t)256 * DM, 256, nullptr}; pg8::gemm_phase(ring, g, S, E); } SEAM(pb + 12); }
        if (IN(pb + 13)) { _Pragma("unroll 1") for (int rep_ = 0; rep_ < NREP(pb + 13); ++rep_) { PTRS(); resnorm_rows(F, Y, ap->in[20] + (size_t)l * DM, H, (rep_ + 1 < NREP(pb + 13)) ? MERGED : H, (rep_ + 1 < NREP(pb + 13)) ? RS + SEQ : RS, nullptr, ws + WS_XB8, RSQ); } SEAM(pb + 13); }
        if (IN(pb + 14)) { _Pragma("unroll 1") for (int rep_ = 0; rep_ < NREP(pb + 14); ++rep_) { PTRS();
#pragma unroll 1
            for (int hh = 0; hh < UP_SPLIT; ++hh) { constexpr int TPC = 86 / UP_SPLIT;
                pg8::Gemm g; g.A = ws + WS_XB8 - DM; g.B = wl + WO_UP + (size_t)hh * TPC * 256 * DM; g.tsA = (size_t)254 * DM; g.pnA = 0; g.tsB = (size_t)256 * DM; g.pmB = 0; g.rsA = DM; g.rsB = DM;
                g.hsA = (size_t)128 * DM; g.hsB = (size_t)128 * DM; g.nM = 65; g.nN = TPC; g.nt = DM / 128;
                pg8::StaticOrder S; S.init(g.nM, g.nN, G, bid);
                pg8::EpiUpConv E{ACTB, ap->in[29] + (size_t)l * 3 * N_UP, ap->in[30] + (size_t)l * N_UP, RSQ, (const float*)(ws + WS_CS + (size_t)l * CS_LAYER + CS_UP), (LAS float*)(F.lds + EPX_OFF), hh * TPC}; pg8::gemm_phase<pg8::EpiUpConv, 2>(ring, g, S, E);
                if (UP_SPLIT > 1 && hh + 1 < UP_SPLIT && IN(pb + 15)) { XcdBarrier bar_; bar_.bar = (unsigned*)(KARGS()->ws + WS_CTL) + CW_BAR; bar_.x = xb_xcc_id(); bar_.st = (volatile LAS unsigned*)(ring + MISC_OFF) + 8; xcd_barrier(bar_); } }
            } SEAM(pb + 14); }
        if (IN(pb + 16)) { _Pragma("unroll 1") for (int rep_ = 0; rep_ < NREP(pb + 16); ++rep_) { PTRS(); pg8::Gemm g = pg8::make_gemm(ACTB, D_FF, (const bf16_t*)(wl + WO_DOWN), D_FF, SEQ, DM, D_FF); pg8::StaticOrder S; S.init(g.nM, g.nN, G, bid);
            pg8::EpiStore E{Y, DM, (size_t)256 * DM, 256, nullptr}; pg8::gemm_phase(ring, g, S, E); } SEAM(pb + 16); }
        if (IN(pb + 17)) { _Pragma("unroll 1") for (int rep_ = 0; rep_ < NREP(pb + 17); ++rep_) { PTRS(); resnorm_rows(F, Y, ap->in[27] + (size_t)l * DM, H, (rep_ + 1 < NREP(pb + 17)) ? MERGED : H, (rep_ + 1 < NREP(pb + 17)) ? RS + SEQ : RS, l + 1 < DEPTH ? nullptr : X, l + 1 < DEPTH ? ws + WS_XB8 : nullptr, RSQ); } SEAM(pb + 17); }
    }
#if MK_CHECK
    if (hi == N_PHASES) check_finish(ring, ctl, KARGS()->out);
#endif
#undef IN
#undef SEAM
#undef lo
#undef hi
}


static void add_job(Args& a, int& nj, const float* src, int K, int pitch, int n0, int ncols, bf16_t* dst, const float* gain = nullptr) {
    TrJob& j = a.jobs[nj++]; j.src = src; j.dst = dst; j.gain = gain; j.cs = nullptr; j.mode = 0; j.pad = 0; j.K = K; j.pitch = pitch; j.n0 = n0; j.ncols = ncols;
}
extern "C" void kernel_launch(void* const* d_in, const int* in_sizes, int n_in, void* d_out, int out_size, void* d_ws, size_t ws_size, hipStream_t stream) {
    static int grid = 0;
    if (grid == 0) {
        if (n_in != 32 || out_size != SEQ * DM || ws_size < WS_END) { fprintf(stderr, "kernel_launch: unexpected shapes (n_in %d, out %d, ws %zu, need %zu)\n", n_in, out_size, ws_size, (size_t)WS_END); grid = -1; return; }
        int dev = 0, cus = 0, per_cu = 0;
        if (hipGetDevice(&dev) != hipSuccess || hipDeviceGetAttribute(&cus, hipDeviceAttributeMultiprocessorCount, dev) != hipSuccess) { grid = -1; return; }
        if (hipFuncSetAttribute((const void*)enc_fwd, hipFuncAttributeMaxDynamicSharedMemorySize, LDS_BYTES) != hipSuccess) { fprintf(stderr, "kernel_launch: hipFuncSetAttribute failed\n"); grid = -1; return; }
        if (hipOccupancyMaxActiveBlocksPerMultiprocessor(&per_cu, (const void*)enc_fwd, 512, LDS_BYTES) != hipSuccess || per_cu < 1) { fprintf(stderr, "kernel_launch: occupancy query says %d blocks per CU\n", per_cu); (void)hipGetLastError(); grid = -1; return; }
        grid = cus;
    }
    if (grid < 0) return;
    (void)hipMemsetAsync((char*)d_ws + WS_CTL, 0, CTL_BYTES, stream);
    Args a; memset(&a, 0, sizeof(a));
    for (int i = 0; i < 32; ++i) a.in[i] = (const float*)d_in[i];
    a.out = (float*)d_out; a.ws = (unsigned char*)d_ws;
    int nj = 0;
    for (int l = 0; l < DEPTH; ++l) {
        unsigned char* wl = (unsigned char*)d_ws + WS_W + (size_t)l * W_LAYER;
        const float* w_in = a.in[5] + (size_t)l * DM * N_IN; bf16_t* ing = (bf16_t*)(wl + WO_ING);
        const float* g_mix = a.in[3] + (size_t)l * DM; const float* g_mem = a.in[19] + (size_t)l * DM; const float* g_ffn = a.in[26] + (size_t)l * DM;
        unsigned char* q8 = wl + WO_ING + WOI_Q8; float* csq = (float*)((unsigned char*)d_ws + WS_CS + (size_t)l * CS_LAYER);
        constexpr int FB = F_INT8 ? 0 : 1024;
        add_job(a, nj, w_in, DM, N_IN, 1024, 1280, ing + (size_t)FB * DM, g_mix);
        add_job(a, nj, w_in, DM, N_IN, 2304, 64, ing + (size_t)(FB + 1280) * DM, g_mix);
        if (F_INT8) { add_job(a, nj, w_in, DM, N_IN, 0, 1024, (bf16_t*)q8, g_mix); a.jobs[nj - 1].mode = 4; a.jobs[nj - 1].cs = csq; }
        else add_job(a, nj, w_in, DM, N_IN, 0, 1024, ing, g_mix);
        add_job(a, nj, w_in, DM, N_IN, 2368, 4096, (bf16_t*)(q8 + (size_t)(N_ZQ - 4096) * DM), g_mix); a.jobs[nj - 1].mode = 4; a.jobs[nj - 1].cs = csq + (N_ZQ - 4096);
        add_job(a, nj, a.in[16] + (size_t)l * DM * N_GATE, DM, N_GATE, 0, N_GATE, (bf16_t*)(q8 + (size_t)N_ZQ * DM), g_mix); a.jobs[nj - 1].mode = 4; a.jobs[nj - 1].cs = csq + N_ZQ;
        add_job(a, nj, a.in[7] + (size_t)l * Q_LORA * NQ, Q_LORA, NQ, 0, NQ, (bf16_t*)(wl + WO_UQ));
        add_job(a, nj, a.in[9] + (size_t)l * KV_LORA * NKV, KV_LORA, NKV, 0, NKV, (bf16_t*)(wl + WO_UKV));
        add_job(a, nj, a.in[13] + (size_t)l * F_WIDTH * DM, F_WIDTH, DM, 0, DM, (bf16_t*)(wl + WO_BRF));
        add_job(a, nj, a.in[14] + (size_t)l * 1024 * DM, 1024, DM, 0, DM, (bf16_t*)(wl + WO_BRA));
        add_job(a, nj, a.in[15] + (size_t)l * SG_WIDTH * DM, SG_WIDTH, DM, 0, DM, (bf16_t*)(wl + WO_BRS));
        add_job(a, nj, a.in[18] + (size_t)l * DM * DM, DM, DM, 0, DM, (bf16_t*)(wl + WO_OUT));
        add_job(a, nj, a.in[22] + (size_t)l * DM * MEM_W, DM, MEM_W, 0, MEM_W, (bf16_t*)(wl + WO_MQ), g_mem);
        add_job(a, nj, a.in[23] + (size_t)l * DM * MEM_W, DM, MEM_W, 0, MEM_W, (bf16_t*)(wl + WO_MK));
        add_job(a, nj, a.in[24] + (size_t)l * DM * MEM_W, DM, MEM_W, 0, MEM_W, (bf16_t*)(wl + WO_MV));
        add_job(a, nj, a.in[25] + (size_t)l * MEM_W * DM, MEM_W, DM, 0, DM, (bf16_t*)(wl + WO_MO));
        add_job(a, nj, a.in[28] + (size_t)l * DM * N_UP, DM, N_UP, 0, N_UP, (bf16_t*)(wl + WO_UP), g_ffn); a.jobs[nj - 1].mode = 5; a.jobs[nj - 1].cs = (float*)((unsigned char*)d_ws + WS_CS + (size_t)l * CS_LAYER + CS_UP);
        add_job(a, nj, a.in[31] + (size_t)l * D_FF * DM, D_FF, DM, 0, DM, (bf16_t*)(wl + WO_DOWN));
    }
#if MK_N_LAUNCHES == 1
    a.ph_lo = 0; a.ph_hi = N_PHASES;
    hipLaunchKernelGGL(enc_fwd, dim3(grid), dim3(512), LDS_BYTES, stream, a);
#else
    for (int k = 0; k < N_PHASES; ++k) { a.ph_lo = k; a.ph_hi = k + 1; hipLaunchKernelGGL(enc_fwd, dim3(grid), dim3(512), LDS_BYTES, stream, a); }
#endif
    const hipError_t le = hipPeekAtLastError();
    if (le != hipSuccess) fprintf(stderr, "kernel_launch: launch failed: %s\n", hipGetErrorName(le));
}
```
